# Optimizing an MI355X kernel written in HIP

```python
import math
import jax, jax.numpy as jnp
from jax import lax
import numpy as np

D_MODEL = 1024
BATCH = 8
SEQ = 4096
DEPTH = 1

CTX_LEN = 256
GRID_W = 64
D_MIX = D_MODEL
D_S5 = D_MIX // 2
D_HY = D_MIX - D_S5
S5_GROUP = 16
S5_GROUPS = D_S5 // S5_GROUP
S5_STATE = 64
S5_DT_MIN = 1e-3
S5_DT_MAX = 1e-1
HY_ORDER = 2
HY_BANDS = 16
HY_EMB = 1 + 2 * HY_BANDS
HY_FILTER_HIDDEN = 64
HY_DECAY_TARGET = 1e-2
HY_FAST_DECAY = 0.3
HY_SLOW_DECAY = 1.5
SHORT_CONV = 3
D_FF = 4 * D_MODEL
N_MOD = 6
POS_BASE = 10000.0
EPS = 1e-6

kernel_name = "hymba_s5_hyena_prefix_dit_block"


def rmsnorm(x, g):
    xf = x.astype(jnp.float32)
    y = xf * lax.rsqrt(jnp.mean(xf * xf, axis=-1, keepdims=True) + EPS)
    return (y * g.astype(jnp.float32)).astype(x.dtype)


def pos_embed_2d(n, d):
    rows = n // GRID_W
    row = jnp.repeat(jnp.arange(rows, dtype=jnp.float32), GRID_W)
    col = jnp.tile(jnp.arange(GRID_W, dtype=jnp.float32), rows)
    quarter = d // 4
    omega = 1.0 / (POS_BASE ** (jnp.arange(quarter, dtype=jnp.float32) / quarter))

    def enc(p):
        ang = p[:, None] * omega[None, :]
        return jnp.concatenate([jnp.sin(ang), jnp.cos(ang)], axis=-1)

    return jnp.concatenate([enc(row), enc(col)], axis=-1)


def _linear_recurrence(left, right):
    a1, b1 = left
    a2, b2 = right
    return a1 * a2, a2 * b1 + b2


def s5_discretize(a_re, a_im, log_step, b_re, b_im):
    lam = lax.complex(a_re.astype(jnp.float32), a_im.astype(jnp.float32))
    step = jnp.exp(log_step.astype(jnp.float32))[:, None]
    lam_bar = jnp.exp(lam * step)
    bmat = lax.complex(b_re.astype(jnp.float32), b_im.astype(jnp.float32))
    b_bar = ((lam_bar - 1.0) / lam)[..., None] * bmat
    return lam_bar, b_bar


def s5_scan(u, lam_bar, b_bar, s0, reverse):
    bu = jnp.einsum('blgc,gpc->lbgp', u.astype(jnp.complex64), b_bar)
    if s0 is not None:
        edge = bu.shape[0] - 1 if reverse else 0
        bu = bu.at[edge].add(lam_bar[None] * s0)
    a = jnp.broadcast_to(lam_bar[None, None], (bu.shape[0], 1) + lam_bar.shape)
    _, states = lax.associative_scan(_linear_recurrence, (a, bu), reverse=reverse)
    return states


def s5_mixer(u, u_ctx, a_re, a_im, log_step, b_re, b_im, c_re, c_im, d_skip, glu_w, glu_b):
    bsz, n, _ = u.shape
    uf = u.astype(jnp.float32).reshape(bsz, n, S5_GROUPS, S5_GROUP)
    uc = u_ctx.astype(jnp.float32).reshape(bsz, u_ctx.shape[1], S5_GROUPS, S5_GROUP)
    outs = []
    for direction, reverse in enumerate((False, True)):
        lam_bar, b_bar = s5_discretize(a_re[direction], a_im[direction], log_step[direction],
                                       b_re[direction], b_im[direction])
        ctx_states = s5_scan(uc, lam_bar, b_bar, None, reverse)
        s0 = ctx_states[0] if reverse else ctx_states[-1]
        states = s5_scan(uf, lam_bar, b_bar, s0, reverse)
        c_mat = lax.complex(c_re[direction].astype(jnp.float32),
                            c_im[direction].astype(jnp.float32))
        outs.append(jnp.real(jnp.einsum('lbgp,gcp->blgc', states, c_mat)))
    y = outs[0] + outs[1] + uf * d_skip.astype(jnp.float32).reshape(S5_GROUPS, S5_GROUP)
    y = jax.nn.gelu(y.reshape(bsz, n, D_S5))
    ab = jnp.einsum('bld,de->ble', y, glu_w.astype(jnp.float32)) + glu_b.astype(jnp.float32)
    val, gate = jnp.split(ab, 2, axis=-1)
    return (val * jax.nn.sigmoid(gate)).astype(u.dtype)


def short_conv(x, w, b):
    xp = jnp.pad(x, ((0, 0), (1, 1), (0, 0)))
    return xp[:, :-2] * w[0] + xp[:, 1:-1] * w[1] + xp[:, 2:] * w[2] + b


def hyena_filters(n, w1, b1, w2, b2, freq, w3, decay):
    f32 = jnp.float32
    t = jnp.linspace(0.0, 1.0, n, dtype=f32)[:, None]
    w = 2.0 * math.pi * jnp.arange(n, dtype=f32) / n
    bands = jnp.linspace(1e-4, HY_BANDS - 1, HY_BANDS, dtype=f32)
    ang = w[:, None] * bands[None, :]
    emb = jnp.concatenate([t, jnp.cos(ang), -jnp.sin(ang)], axis=-1)
    fr = freq.astype(f32)
    h = jnp.sin(fr * (emb @ w1.astype(f32) + b1.astype(f32)))
    h = jnp.sin(fr * (h @ w2.astype(f32) + b2.astype(f32)))
    h = (h @ w3.astype(f32)).reshape(n, HY_ORDER, 2, D_HY)
    window = jnp.exp(-t[:, :, None] * jnp.abs(decay.astype(f32))[None])
    return h * window[:, :, None, :]


def fft_conv_bidir(u, h_fwd, h_bwd, bias):
    n = u.shape[1]
    filt = jnp.concatenate([h_fwd, jnp.zeros((1, h_fwd.shape[1]), h_fwd.dtype), h_bwd[:0:-1]], axis=0)
    u_f = jnp.fft.rfft(u, n=2 * n, axis=1)
    k_f = jnp.fft.rfft(filt, n=2 * n, axis=0)
    y = jnp.fft.irfft(u_f * k_f[None], n=2 * n, axis=1)[:, :n]
    return y + u * bias


def hyena_mixer(z_in, conv_w, conv_b, f_w1, f_b1, f_w2, f_b2, f_freq, f_w3, decay, bias):
    f32 = jnp.float32
    n = z_in.shape[1]
    zc = short_conv(z_in.astype(f32), conv_w.astype(f32), conv_b.astype(f32))
    v, x1, x2 = jnp.split(zc, 3, axis=-1)
    filt = hyena_filters(n, f_w1, f_b1, f_w2, f_b2, f_freq, f_w3, decay)
    z = v
    for order, gate in enumerate((x1, x2)):
        z = gate * fft_conv_bidir(z, filt[:, order, 0], filt[:, order, 1], bias[order].astype(f32))
    return z.astype(z_in.dtype)


def setup_inputs(seed: int = 0) -> dict:
    key = jax.random.key(seed)
    ks = iter(jax.random.split(key, 48))
    f32 = jnp.float32

    def nrm(shape, scale):
        return jax.random.normal(next(ks), shape, f32) * scale

    G, P, C, H = S5_GROUPS, S5_STATE, S5_GROUP, HY_FILTER_HIDDEN
    min_decay = math.log(HY_DECAY_TARGET) / HY_SLOW_DECAY
    max_decay = math.log(HY_DECAY_TARGET) / HY_FAST_DECAY
    decay_lin = jnp.abs(jnp.linspace(min_decay, max_decay, D_HY, dtype=f32))
    return {
        "x": nrm((BATCH, SEQ, D_MODEL), 1.0),
        "c": nrm((BATCH, D_MODEL), 1.0),
        "ctx": nrm((BATCH, CTX_LEN, D_MODEL), 1.0),
        "c_ctx": nrm((D_MODEL,), 1.0),
        "ada_w": nrm((DEPTH, D_MODEL, N_MOD * D_MODEL), 0.5 * D_MODEL ** -0.5),
        "ada_b": nrm((DEPTH, N_MOD * D_MODEL), 0.02),
        "norm1_g": 1.0 + nrm((DEPTH, D_MODEL), 0.02),
        "w_in": nrm((DEPTH, D_MODEL, D_S5 + 3 * D_HY), D_MODEL ** -0.5),
        "s5_a_re": -0.5 + nrm((DEPTH, 2, G, P), 0.01),
        "s5_a_im": math.pi * jnp.arange(P, dtype=f32) + nrm((DEPTH, 2, G, P), 0.01),
        "s5_log_step": jax.random.uniform(next(ks), (DEPTH, 2, G), f32,
                                          math.log(S5_DT_MIN), math.log(S5_DT_MAX)),
        "s5_b_re": nrm((DEPTH, 2, G, P, C), (2 * C) ** -0.5),
        "s5_b_im": nrm((DEPTH, 2, G, P, C), (2 * C) ** -0.5),
        "s5_c_re": nrm((DEPTH, 2, G, C, P), (2 * P) ** -0.5),
        "s5_c_im": nrm((DEPTH, 2, G, C, P), (2 * P) ** -0.5),
        "s5_d": nrm((DEPTH, D_S5), 1.0),
        "s5_glu_w": nrm((DEPTH, D_S5, 2 * D_S5), D_S5 ** -0.5),
        "s5_glu_b": nrm((DEPTH, 2 * D_S5), 0.02),
        "hy_conv_w": nrm((DEPTH, SHORT_CONV, 3 * D_HY), SHORT_CONV ** -0.5),
        "hy_conv_b": nrm((DEPTH, 3 * D_HY), 0.02),
        "hy_f_w1": nrm((DEPTH, HY_EMB, H), HY_EMB ** -0.5),
        "hy_f_b1": nrm((DEPTH, H), 0.02),
        "hy_f_w2": nrm((DEPTH, H, H), H ** -0.5),
        "hy_f_b2": nrm((DEPTH, H), 0.02),
        "hy_f_freq": 1.0 + nrm((DEPTH, H), 0.02),
        "hy_f_w3": nrm((DEPTH, H, HY_ORDER * 2 * D_HY), H ** -0.5),
        "hy_decay": decay_lin * (1.0 + nrm((DEPTH, HY_ORDER, D_HY), 0.02)),
        "hy_bias": nrm((DEPTH, HY_ORDER, D_HY), 1.0),
        "mix_g_s5": 1.0 + nrm((DEPTH, D_S5), 0.02),
        "mix_g_hy": 1.0 + nrm((DEPTH, D_HY), 0.02),
        "w_out": nrm((DEPTH, D_MIX, D_MODEL), D_MIX ** -0.5),
        "norm2_g": 1.0 + nrm((DEPTH, D_MODEL), 0.02),
        "mlp_w1": nrm((DEPTH, D_MODEL, D_FF), D_MODEL ** -0.5),
        "mlp_w2": nrm((DEPTH, D_FF, D_MODEL), D_FF ** -0.5),
        "final_g": 1.0 + nrm((D_MODEL,), 0.02),
    }


def reference(x, c, ctx, c_ctx, ada_w, ada_b, norm1_g, w_in,
              s5_a_re, s5_a_im, s5_log_step, s5_b_re, s5_b_im, s5_c_re, s5_c_im,
              s5_d, s5_glu_w, s5_glu_b,
              hy_conv_w, hy_conv_b, hy_f_w1, hy_f_b1, hy_f_w2, hy_f_b2, hy_f_freq,
              hy_f_w3, hy_decay, hy_bias,
              mix_g_s5, mix_g_hy, w_out, norm2_g, mlp_w1, mlp_w2, final_g):
    n = x.shape[1]
    h = x + pos_embed_2d(n, D_MODEL).astype(x.dtype)[None]
    c_act = jax.nn.silu(c)
    c_ctx_act = jax.nn.silu(c_ctx)
    for i in range(DEPTH):
        mod = c_act @ ada_w[i] + ada_b[i]
        shift1, scale1, gate1, shift2, scale2, gate2 = jnp.split(mod[:, None, :], N_MOD, axis=-1)
        mod_ctx = c_ctx_act @ ada_w[i] + ada_b[i]
        shift1_c, scale1_c = mod_ctx[:D_MODEL], mod_ctx[D_MODEL:2 * D_MODEL]

        hn = rmsnorm(h, norm1_g[i]) * (1.0 + scale1) + shift1
        proj = hn @ w_in[i]
        u_s5 = proj[..., :D_S5]
        z_hy = proj[..., D_S5:]
        cn = rmsnorm(ctx, norm1_g[i]) * (1.0 + scale1_c) + shift1_c
        u_ctx = cn @ w_in[i][:, :D_S5]

        y_s5 = s5_mixer(u_s5, u_ctx, s5_a_re[i], s5_a_im[i], s5_log_step[i],
                        s5_b_re[i], s5_b_im[i], s5_c_re[i], s5_c_im[i],
                        s5_d[i], s5_glu_w[i], s5_glu_b[i])
        y_hy = hyena_mixer(z_hy, hy_conv_w[i], hy_conv_b[i], hy_f_w1[i], hy_f_b1[i],
                           hy_f_w2[i], hy_f_b2[i], hy_f_freq[i], hy_f_w3[i],
                           hy_decay[i], hy_bias[i])
        mix = jnp.concatenate([rmsnorm(y_s5, mix_g_s5[i]), rmsnorm(y_hy, mix_g_hy[i])], axis=-1)
        h = h + gate1 * (mix @ w_out[i])

        hn2 = rmsnorm(h, norm2_g[i]) * (1.0 + scale2) + shift2
        hid = jnp.square(jax.nn.relu(hn2 @ mlp_w1[i]))
        h = h + gate2 * (hid @ mlp_w2[i])
    return rmsnorm(h, final_g)
```

```cpp
#include <hip/hip_runtime.h>
#include <hip/hip_cooperative_groups.h>
#include <stdint.h>
#include <stdio.h>
#include <string.h>
namespace cg = cooperative_groups;

#define NT 512
#define LDS_BYTES (131072 + 16)
#define N_PHASES 14
#ifndef MULTI_LAUNCH
#define MULTI_LAUNCH 0
#endif

typedef unsigned short bf16_t;
using bf16x8 = __attribute__((ext_vector_type(8))) short;
using f32x4 = __attribute__((ext_vector_type(4))) float;

#define MiB ((size_t)1 << 20)
#define OFF_WTIN (0 * MiB)
#define OFF_WTGLU (4 * MiB)
#define OFF_WTOUT (5 * MiB)
#define OFF_WT1 (7 * MiB)
#define OFF_WT2 (15 * MiB)
#define OFF_S5WIN (23 * MiB)
#define OFF_S5WCAT (27 * MiB)
#define OFF_MOD (35 * MiB)
#define OFF_POS (36 * MiB)
#define OFF_A1 (37 * MiB)
#define OFF_YS5 (105 * MiB)
#define OFF_A2 (137 * MiB)
#define OFF_SLOC (205 * MiB)
#define OFF_Z (273 * MiB)
#define OFF_FILT (369 * MiB)
#define OFF_YS5G (401 * MiB)
#define OFF_HID (137 * MiB)
#define OFF_Z1 (433 * MiB)
#define OFF_BAR (465 * MiB)
#define WS_NEED (466 * MiB)

struct Params {
  const float* in[35];
  float* out;
  unsigned char* ws;
  int ph_lo, ph_hi;
};

__device__ __forceinline__ unsigned short f2bf(float f) {
  unsigned u = __float_as_uint(f);
  u += 0x7fffu + ((u >> 16) & 1u);
  return (unsigned short)(u >> 16);
}
__device__ __forceinline__ float bf2f(unsigned short h) { return __uint_as_float(((unsigned)h) << 16); }
__device__ __forceinline__ unsigned pack2(float a, float b) { return (unsigned)f2bf(a) | ((unsigned)f2bf(b) << 16); }
__device__ __forceinline__ float sinrev(float r) { return __builtin_amdgcn_sinf(r); }
__device__ __forceinline__ float cosrev(float r) { return __builtin_amdgcn_cosf(r); }
#define INV2PI 0.15915494309189535f
__device__ __forceinline__ float hsin(float x) { return __builtin_amdgcn_sinf(x * INV2PI); }
__device__ __forceinline__ float hcos(float x) { return __builtin_amdgcn_cosf(x * INV2PI); }
__device__ __forceinline__ float wave_sum(float v) {
#pragma unroll
  for (int o = 32; o >= 1; o >>= 1) v += __shfl_xor(v, o, 64);
  return v;
}
__device__ __forceinline__ float gelu_tanh(float x) {
  float z = 0.7978845608028654f * (x + 0.044715f * x * x * x);
  float e = __expf(2.0f * z);
  float t = 1.0f - 2.0f / (e + 1.0f);
  return 0.5f * x * (1.0f + t);
}

struct ALin {
  const bf16_t* p; int ld;
  __device__ __forceinline__ const bf16_t* operator()(int m, int k) const { return p + (unsigned)(m * ld + k); }
};
struct ABlk {
  const bf16_t* p; int M;
  __device__ __forceinline__ const bf16_t* operator()(int m, int k) const {
    return p + (unsigned)(((k >> 5) * M + m) * 32 + (k & 31));
  }
};
struct AGlu {
  const bf16_t* p;
  __device__ __forceinline__ const bf16_t* operator()(int m, int k) const {
    return p + (unsigned)(((k >> 4) * 32768 + m) * 16 + (k & 15));
  }
};

#define G_DMA(STEP, STAGE_OFF)                                                                     \
  {                                                                                                \
    const int s_ = min((STEP), ns - 1);                                                            \
    _Pragma("unroll") for (int i = 0; i < 4; ++i) {                                                \
      const int p_ = wave * 4 + i;                                                                 \
      const bf16_t* g_;                                                                            \
      if (wave < 4) g_ = af(min(m0 + p_ * 16 + (lane >> 2), mmax - 1), s_ * 32 + dchunk * 8);      \
      else g_ = W + (unsigned)((s_ * ldw + n0 + (p_ - 16) * 16 + (lane >> 2)) * 32 + dchunk * 8); \
      __builtin_amdgcn_global_load_lds((const unsigned*)g_, (unsigned*)(smem + (STAGE_OFF) + p_ * 1024 + lane * 16), 16, 0, 0); \
    }                                                                                              \
  }
#define G_READ_LO(OFF, FAL)                                                                        \
  {                                                                                                \
    const unsigned char* pa_ = smem + (OFF) + rdA_off;                                             \
    _Pragma("unroll") for (int mt = 0; mt < 4; ++mt) FAL[mt] = *(const bf16x8*)(pa_ + mt * 16 * 64); \
  }
#define G_READ_B(OFF, FB)                                                                          \
  {                                                                                                \
    const unsigned char* pb_ = smem + (OFF) + rdB_off;                                             \
    _Pragma("unroll") for (int nt = 0; nt < 4; ++nt) FB[nt] = *(const bf16x8*)(pb_ + nt * 16 * 64); \
  }
#define G_READ_HI(OFF, FAH)                                                                        \
  {                                                                                                \
    const unsigned char* pa_ = smem + (OFF) + rdA_off + 64 * 64;                                   \
    _Pragma("unroll") for (int mt = 0; mt < 4; ++mt) FAH[mt] = *(const bf16x8*)(pa_ + mt * 16 * 64); \
  }
#define G_MMA_H(H, FA, FB)                                                                         \
  {                                                                                                \
    _Pragma("unroll") for (int mt = 0; mt < 4; ++mt)                                               \
      _Pragma("unroll") for (int nt = 0; nt < 4; ++nt)                                             \
        acc[(H) * 4 + mt][nt] = __builtin_amdgcn_mfma_f32_16x16x32_bf16(FB[nt], FA[mt], acc[(H) * 4 + mt][nt], 0, 0, 0); \
  }
#define SB __builtin_amdgcn_sched_barrier(0)
#define WAIT_BAR(N) asm volatile("s_waitcnt vmcnt(" #N ")\n\ts_barrier" ::: "memory")
#define STAGE_B 32768

template <class AF>
__device__ __forceinline__ void gemm_tile(unsigned char* smem, const AF& af, const bf16_t* __restrict__ W, int ldw,
                                          int nk, int m0, int n0, int mmax, f32x4 (&acc)[8][4]) {
  const int tid = threadIdx.x, lane = tid & 63, wave = tid >> 6;
  const int wm = wave >> 2, wn = wave & 3;
  const int r = lane & 15, q = lane >> 4;
  const int ns = nk * 2;
#pragma unroll
  for (int i = 0; i < 8; ++i)
#pragma unroll
    for (int j = 0; j < 4; ++j) acc[i][j] = (f32x4){0.f, 0.f, 0.f, 0.f};
  const int dchunk = (lane & 3) ^ ((4 - ((lane >> 4) & 3)) & 3);
  const int rpos = (q ^ ((4 - ((r >> 2) & 3)) & 3)) << 4;
  const int rdA_off = (wm * 128 + r) * 64 + rpos;
  const int rdB_off = 16384 + (wn * 64 + r) * 64 + rpos;
  bf16x8 fb[4], falA[4], falB[4], fah[4];
  G_DMA(0, 0);
  G_DMA(1, STAGE_B);
  G_DMA(2, 2 * STAGE_B);
  WAIT_BAR(4);
  G_READ_B(0, fb);
  G_READ_LO(0, falA);
  int o0 = 0, o1 = STAGE_B, o2 = 2 * STAGE_B, o3 = 3 * STAGE_B;
#define MID_BAR asm volatile("s_waitcnt lgkmcnt(0)\n\ts_barrier" ::: "memory")
  if (wm == 1) __builtin_amdgcn_s_barrier();
#pragma unroll 1
  for (int t = 0; t < ns; t += 2) {
    G_DMA(t + 3, o3);
    SB;
    G_READ_HI(o0, fah);
    G_MMA_H(0, falA, fb);
    SB;
    MID_BAR;
    G_READ_LO(o1, falB);
    G_MMA_H(1, fah, fb);
    SB;
    G_READ_B(o1, fb);
    WAIT_BAR(4);
    { int tmp = o0; o0 = o1; o1 = o2; o2 = o3; o3 = tmp; }
    G_DMA(t + 4, o3);
    SB;
    G_READ_HI(o0, fah);
    G_MMA_H(0, falB, fb);
    SB;
    MID_BAR;
    G_READ_LO(o1, falA);
    G_MMA_H(1, fah, fb);
    SB;
    G_READ_B(o1, fb);
    WAIT_BAR(4);
    { int tmp = o0; o0 = o1; o1 = o2; o2 = o3; o3 = tmp; }
  }
  if (wm == 0) __builtin_amdgcn_s_barrier();
  asm volatile("s_waitcnt vmcnt(0) lgkmcnt(0)\n\ts_barrier" ::: "memory");
}

__device__ __forceinline__ void wconv_item(const float* __restrict__ src, int N, bf16_t* __restrict__ dst, int kb, int n,
                                           int glu, const float* ks1, const float* ks2) {
  float v[32];
  const float* sp = src + (size_t)(kb * 32) * N + n;
#pragma unroll
  for (int i = 0; i < 32; ++i) v[i] = sp[(size_t)i * N];
  if (ks1) {
#pragma unroll
    for (int i = 0; i < 32; ++i) { int k = kb * 32 + i; v[i] *= (k < 512) ? ks1[k] : ks2[k - 512]; }
  }
  int nd = n;
  if (glu) { int sgl = n >> 9, f = n & 511; nd = 64 * (f >> 5) + 32 * sgl + (f & 31); }
  uint4* dp = (uint4*)(dst + ((size_t)kb * N + nd) * 32);
#pragma unroll
  for (int c = 0; c < 4; ++c) {
    uint4 o;
    o.x = pack2(v[c * 8 + 0], v[c * 8 + 1]); o.y = pack2(v[c * 8 + 2], v[c * 8 + 3]);
    o.z = pack2(v[c * 8 + 4], v[c * 8 + 5]); o.w = pack2(v[c * 8 + 6], v[c * 8 + 7]);
    dp[c] = o;
  }
}

__device__ void job_mod(float* lds, const Params& P, int j) {
  const int tid = threadIdx.x;
  float* sc = lds; float* red = lds + 9216;
  const float* c = P.in[1]; const float* cctx = P.in[3];
  const float* aw = P.in[4]; const float* ab = P.in[5];
  float* mod = (float*)(P.ws + OFF_MOD);
  for (int e = tid; e < 9216; e += NT) {
    int rr = e >> 10, k = e & 1023;
    float v = rr < 8 ? c[rr * 1024 + k] : cctx[k];
    sc[e] = v / (1.0f + __expf(-v));
  }
  __syncthreads();
  const int n0 = j * 64, col = tid & 63, kg = tid >> 6;
  float acc[9];
#pragma unroll
  for (int i = 0; i < 9; ++i) acc[i] = 0.f;
#pragma unroll 16
  for (int k = kg * 128; k < kg * 128 + 128; ++k) {
    float w = aw[(size_t)k * 6144 + n0 + col];
#pragma unroll
    for (int i = 0; i < 9; ++i) acc[i] += sc[i * 1024 + k] * w;
  }
#pragma unroll
  for (int i = 0; i < 9; ++i) red[(kg * 9 + i) * 64 + col] = acc[i];
  __syncthreads();
  for (int e = tid; e < 576; e += NT) {
    int rr = e >> 6, cc = e & 63;
    float s = ab[n0 + cc];
#pragma unroll
    for (int g = 0; g < 8; ++g) s += red[(g * 9 + rr) * 64 + cc];
    mod[rr * 6144 + n0 + cc] = s;
  }
  __syncthreads();
}

__device__ void job_pos(const Params& P) {
  float* E = (float*)(P.ws + OFF_POS);
  for (int e = threadIdx.x; e < 64 * 512; e += NT) {
    int p = e >> 9, d = e & 511, i = d & 255;
    float omega = exp2f(-(float)i * (13.287712379549449f / 256.0f));
    float ang = (float)p * omega;
    E[e] = d < 256 ? hsin(ang) : hcos(ang);
  }
}

__device__ void job_s5mats(float* lds, const Params& P, int g, int sj) {
  const int tid = threadIdx.x;
  float2* pw = (float2*)lds;
  float2* bb = pw + 2 * 17 * 64;
  float2* cc = bb + 2 * 64 * 16;
  float* KK = (float*)(cc + 2 * 16 * 64);
  const float* a_re = P.in[8]; const float* a_im = P.in[9]; const float* lstep = P.in[10];
  const float* b_re = P.in[11]; const float* b_im = P.in[12];
  const float* c_re = P.in[13]; const float* c_im = P.in[14];
  const float* dsk = P.in[15];
  bf16_t* Win = (bf16_t*)(P.ws + OFF_S5WIN) + (size_t)g * 65536;
  bf16_t* Wcat = (bf16_t*)(P.ws + OFF_S5WCAT) + (size_t)g * 131072;
  for (int e = tid; e < 2 * 17 * 64; e += NT) {
    int d = e / 1088, rem = e % 1088, tau = rem >> 6, p = rem & 63;
    float are = a_re[(d * 32 + g) * 64 + p], aim = a_im[(d * 32 + g) * 64 + p];
    float step = __expf(lstep[d * 32 + g]);
    float mag = __expf(are * step * (float)tau);
    float ang = aim * step * (float)tau;
    pw[e] = make_float2(mag * hcos(ang), mag * hsin(ang));
  }
  for (int e = tid; e < 2 * 64 * 16; e += NT) {
    int d = e >> 10, p = (e >> 4) & 63, ch = e & 15;
    float are = a_re[(d * 32 + g) * 64 + p], aim = a_im[(d * 32 + g) * 64 + p];
    float step = __expf(lstep[d * 32 + g]);
    float mag = __expf(are * step);
    float ang = aim * step;
    float nr = mag * hcos(ang) - 1.0f, ni = mag * hsin(ang);
    float den = 1.0f / (are * are + aim * aim);
    float qr = (nr * are + ni * aim) * den, qi = (ni * are - nr * aim) * den;
    size_t bi = ((size_t)((d * 32 + g) * 64 + p)) * 16 + ch;
    float br = b_re[bi], bim = b_im[bi];
    bb[e] = make_float2(qr * br - qi * bim, qr * bim + qi * br);
  }
  for (int e = tid; e < 2 * 16 * 64; e += NT) {
    int d = e >> 10, ch = (e >> 6) & 15, p = e & 63;
    size_t ci = ((size_t)((d * 32 + g) * 16 + ch)) * 64 + p;
    cc[e] = make_float2(c_re[ci], c_im[ci]);
  }
  __syncthreads();
  for (int e0 = tid; e0 < 2048; e0 += NT) {
    int d = e0 >> 10, tau = sj * 4 + ((e0 >> 8) & 3), ch = (e0 >> 4) & 15, ch2 = e0 & 15;
    int e = (d << 12) | (tau << 8) | (ch << 4) | ch2;
    float s = 0.f;
    for (int p = 0; p < 64; ++p) {
      float2 c = cc[(d * 16 + ch) * 64 + p], w = pw[(d * 17 + tau) * 64 + p], b = bb[(d * 64 + p) * 16 + ch2];
      float cr = c.x * w.x - c.y * w.y, ci = c.x * w.y + c.y * w.x;
      s += cr * b.x - ci * b.y;
    }
    KK[e] = s;
  }
  for (int e = tid * 4 + sj; e < 8192; e += NT * 4) {
    int n = e >> 5, k8 = (e & 31) * 8;
    int d = n >> 7, p = (n & 127) >> 1, ri = n & 1;
    int i = k8 >> 4, ch0 = k8 & 15;
    int tau = d == 0 ? 15 - i : i;
    float2 w = pw[(d * 17 + tau) * 64 + p];
    float v[8];
#pragma unroll
    for (int t = 0; t < 8; ++t) {
      float2 b = bb[(d * 64 + p) * 16 + ch0 + t];
      v[t] = ri ? (w.x * b.y + w.y * b.x) : (w.x * b.x - w.y * b.y);
    }
    uint4 o; o.x = pack2(v[0], v[1]); o.y = pack2(v[2], v[3]); o.z = pack2(v[4], v[5]); o.w = pack2(v[6], v[7]);
    *(uint4*)(Win + ((size_t)(k8 >> 5) * 256 + n) * 32 + (k8 & 31)) = o;
  }
  for (int e = tid * 4 + sj; e < 8192; e += NT * 4) {
    int n = e >> 5, k8 = (e & 31) * 8;
    int j = n >> 4, ch = n & 15;
    float v[8];
#pragma unroll
    for (int t = 0; t < 8; ++t) {
      int kk = k8 + t;
      int d = kk >> 7, p = (kk & 127) >> 1, ri = kk & 1;
      int tau = d == 0 ? j + 1 : 16 - j;
      float2 c = cc[(d * 16 + ch) * 64 + p], w = pw[(d * 17 + tau) * 64 + p];
      v[t] = ri ? -(c.x * w.y + c.y * w.x) : (c.x * w.x - c.y * w.y);
    }
    uint4 o; o.x = pack2(v[0], v[1]); o.y = pack2(v[2], v[3]); o.z = pack2(v[4], v[5]); o.w = pack2(v[6], v[7]);
    *(uint4*)(Wcat + ((size_t)((256 + k8) >> 5) * 256 + n) * 32 + (k8 & 31)) = o;
  }
  __syncthreads();
  for (int e = tid; e < 8192; e += NT) {
    int n = e >> 5, k8 = (e & 31) * 8;
    int j = n >> 4, ch = n & 15;
    int i = k8 >> 4, ch0 = k8 & 15;
    if (((i > j ? i - j : j - i) >> 2) != sj) continue;
    float v[8];
#pragma unroll
    for (int t = 0; t < 8; ++t) {
      int ch2 = ch0 + t;
      float s = 0.f;
      if (i <= j) s += KK[((0 * 16 + (j - i)) * 16 + ch) * 16 + ch2];
      if (i >= j) s += KK[((1 * 16 + (i - j)) * 16 + ch) * 16 + ch2];
      if (i == j && ch == ch2) s += dsk[g * 16 + ch];
      v[t] = s;
    }
    uint4 o; o.x = pack2(v[0], v[1]); o.y = pack2(v[2], v[3]); o.z = pack2(v[4], v[5]); o.w = pack2(v[6], v[7]);
    *(uint4*)(Wcat + ((size_t)(k8 >> 5) * 256 + n) * 32 + (k8 & 31)) = o;
  }
  __syncthreads();
}

__device__ void job_filter(float* lds, const Params& P, int it) {
  const int tid = threadIdx.x;
  float* emb = lds;
  float* h1 = lds + 528;
  float* h2s = lds + 528 + 1024;
  const float* w1 = P.in[20]; const float* b1 = P.in[21]; const float* w2 = P.in[22]; const float* b2 = P.in[23];
  const float* fr = P.in[24]; const float* w3 = P.in[25]; const float* decay = P.in[26];
  float* filt = (float*)(P.ws + OFF_FILT);
  const int t0 = it * 16;
  for (int e = tid; e < 16 * 33; e += NT) {
    int tt = e / 33, qq = e % 33;
    int t = t0 + tt;
    float val;
    if (qq == 0) val = (float)t / 4095.0f;
    else {
      int k = (qq - 1) & 15;
      float band = 1e-4f + (float)k * ((15.0f - 1e-4f) / 15.0f);
      float rev = (float)t * band * (1.0f / 4096.0f);
      val = qq <= 16 ? cosrev(rev) : -sinrev(rev);
    }
    emb[e] = val;
  }
  __syncthreads();
  for (int e = tid; e < 1024; e += NT) {
    int tt = e >> 6, m = e & 63;
    float s = b1[m];
#pragma unroll 11
    for (int qq = 0; qq < 33; ++qq) s += emb[tt * 33 + qq] * w1[qq * 64 + m];
    h1[e] = hsin(fr[m] * s);
  }
  __syncthreads();
  for (int e = tid; e < 1024; e += NT) {
    int tt = e >> 6, m = e & 63;
    float s = b2[m];
#pragma unroll 16
    for (int qq = 0; qq < 64; ++qq) s += h1[tt * 64 + qq] * w2[qq * 64 + m];
    h2s[m * 16 + tt] = hsin(fr[m] * s);
  }
  __syncthreads();
  {
    float acc[4][16];
#pragma unroll
    for (int cq = 0; cq < 4; ++cq)
#pragma unroll
      for (int i = 0; i < 16; ++i) acc[cq][i] = 0.f;
#pragma unroll 4
    for (int m = 0; m < 64; ++m) {
      float w[4];
#pragma unroll
      for (int cq = 0; cq < 4; ++cq) w[cq] = w3[m * 2048 + tid + 512 * cq];
      const float4* hp = (const float4*)(h2s + m * 16);
#pragma unroll
      for (int i = 0; i < 4; ++i) {
        float4 h = hp[i];
#pragma unroll
        for (int cq = 0; cq < 4; ++cq) {
          acc[cq][i * 4 + 0] += h.x * w[cq]; acc[cq][i * 4 + 1] += h.y * w[cq];
          acc[cq][i * 4 + 2] += h.z * w[cq]; acc[cq][i * 4 + 3] += h.w * w[cq];
        }
      }
    }
#pragma unroll
    for (int cq = 0; cq < 4; ++cq) {
      int col = tid + 512 * cq;
      int order = col >> 10, dir = (col >> 9) & 1, c = col & 511;
      float dec = fabsf(decay[order * 512 + c]);
      float* dst = filt + ((size_t)((order * 2 + dir) * 512 + c)) * 4096 + t0;
#pragma unroll
      for (int i = 0; i < 4; ++i) {
        float4 o;
        o.x = acc[cq][i * 4 + 0] * __expf(-((float)(t0 + i * 4 + 0) / 4095.0f) * dec);
        o.y = acc[cq][i * 4 + 1] * __expf(-((float)(t0 + i * 4 + 1) / 4095.0f) * dec);
        o.z = acc[cq][i * 4 + 2] * __expf(-((float)(t0 + i * 4 + 2) / 4095.0f) * dec);
        o.w = acc[cq][i * 4 + 3] * __expf(-((float)(t0 + i * 4 + 3) / 4095.0f) * dec);
        *(float4*)(dst + i * 4) = o;
      }
    }
  }
  __syncthreads();
}

__device__ void phase0(unsigned char* smem, const Params& P) {
  float* lds = (float*)smem;
  const int G = gridDim.x;
  {
    const int nthreads = G * NT;
#pragma unroll 1
    for (int it = blockIdx.x * NT + threadIdx.x; it < 376832; it += nthreads) {
      int u = it;
      if (u < 65536) wconv_item(P.in[7], 2048, (bf16_t*)(P.ws + OFF_WTIN), u >> 11, u & 2047, 0, nullptr, nullptr);
      else if ((u -= 65536) < 16384) wconv_item(P.in[16], 1024, (bf16_t*)(P.ws + OFF_WTGLU), u >> 10, u & 1023, 1, nullptr, nullptr);
      else if ((u -= 16384) < 32768) wconv_item(P.in[30], 1024, (bf16_t*)(P.ws + OFF_WTOUT), u >> 10, u & 1023, 0, P.in[28], P.in[29]);
      else if ((u -= 32768) < 131072) wconv_item(P.in[32], 4096, (bf16_t*)(P.ws + OFF_WT1), u >> 12, u & 4095, 0, nullptr, nullptr);
      else { u -= 131072; wconv_item(P.in[33], 1024, (bf16_t*)(P.ws + OFF_WT2), u >> 10, u & 1023, 0, nullptr, nullptr); }
    }
  }
#pragma unroll 1
  for (int w = blockIdx.x; w < 256; w += G) job_filter(lds, P, w);
#pragma unroll 1
  for (int w = (blockIdx.x + 128) % G; w < 128; w += G) job_s5mats(lds, P, w >> 2, w & 3);
#pragma unroll 1
  for (int w = blockIdx.x; w < 96; w += G) job_mod(lds, P, w);
  if (blockIdx.x == 100) job_pos(P);
}

#define NRF 4
__device__ __forceinline__ void phase_rownorm(const Params& P, int mode) {
  const int lane = threadIdx.x & 63, wave = threadIdx.x >> 6;
  const float* mod = (const float*)(P.ws + OFF_MOD);
  const float* E = (const float*)(P.ws + OFF_POS);
  bf16_t* A1 = (bf16_t*)(P.ws + OFF_A1);
  const bool first = (mode == 0 || mode == 3);
  const int nrows = mode == 3 ? 34816 : 32768;
  const float* gain = first ? P.in[6] : (mode == 1 ? P.in[31] : P.in[34]);
  const int sh_off = first ? 0 : 3072, sc_off = first ? 1024 : 4096;
  const int nblk = mode == 0 ? (int)gridDim.x - 16 : (int)gridDim.x;
  const int bid = mode == 0 ? (int)blockIdx.x - 16 : (int)blockIdx.x;
  const int stride = nblk * 8;
  const int rbeg = mode == 3 ? 32768 : 0;
#pragma unroll 1
  for (int row0 = rbeg + bid * 8 + wave; row0 < nrows; row0 += NRF * stride) {
    float4 v[NRF][4];
    float ss[NRF];
    int bsel[NRF];
#pragma unroll
    for (int j = 0; j < NRF; ++j) {
      int row = min(row0 + j * stride, nrows - 1);
      const float* src;
      if (first) {
        if (row < 32768) { src = P.in[0] + (size_t)row * 1024; bsel[j] = row >> 12; }
        else { src = P.in[2] + (size_t)(row - 32768) * 1024; bsel[j] = 8; }
      } else { src = P.out + (size_t)row * 1024; bsel[j] = row >> 12; }
#pragma unroll
      for (int i = 0; i < 4; ++i) v[j][i] = *(const float4*)(src + lane * 4 + 256 * i);
    }
#pragma unroll
    for (int j = 0; j < NRF; ++j) {
      int row = min(row0 + j * stride, nrows - 1);
      float s = 0.f;
#pragma unroll
      for (int i = 0; i < 4; ++i) {
        int d = lane * 4 + 256 * i;
        if (first && row < 32768) {
          int l = row & 4095;
          float4 e = (i < 2) ? *(const float4*)(E + (l >> 6) * 512 + d) : *(const float4*)(E + (l & 63) * 512 + d - 512);
          v[j][i].x += e.x; v[j][i].y += e.y; v[j][i].z += e.z; v[j][i].w += e.w;
        }
        s += v[j][i].x * v[j][i].x + v[j][i].y * v[j][i].y + v[j][i].z * v[j][i].z + v[j][i].w * v[j][i].w;
      }
      ss[j] = s;
    }
#pragma unroll
    for (int j = 0; j < NRF; ++j) ss[j] = wave_sum(ss[j]);
#pragma unroll
    for (int j = 0; j < NRF; ++j) {
      int row = row0 + j * stride;
      if (row >= nrows) continue;
      const int b = bsel[j];
      float rinv = rsqrtf(ss[j] * (1.0f / 1024.0f) + 1e-6f);
#pragma unroll
      for (int i = 0; i < 4; ++i) {
        int d = lane * 4 + 256 * i;
        float4 g = *(const float4*)(gain + d);
        float4 o;
        o.x = v[j][i].x * rinv * g.x; o.y = v[j][i].y * rinv * g.y; o.z = v[j][i].z * rinv * g.z; o.w = v[j][i].w * rinv * g.w;
        if (mode == 2) {
          *(float4*)(P.out + (size_t)row * 1024 + d) = o;
        } else {
          float4 sc = *(const float4*)(mod + b * 6144 + sc_off + d);
          float4 sh = *(const float4*)(mod + b * 6144 + sh_off + d);
          o.x = o.x * (1.0f + sc.x) + sh.x; o.y = o.y * (1.0f + sc.y) + sh.y;
          o.z = o.z * (1.0f + sc.z) + sh.z; o.w = o.w * (1.0f + sc.w) + sh.w;
          uint2 pk; pk.x = pack2(o.x, o.y); pk.y = pack2(o.z, o.w);
          *(uint2*)(A1 + ((size_t)(d >> 5) * 34816 + row) * 32 + (d & 31)) = pk;
        }
      }
    }
  }
}

__device__ __forceinline__ void tile_map(int t, int lg, int& tm, int& tn) {
  if (gridDim.x != 256) { tm = t >> lg; tn = t & ((1 << lg) - 1); return; }
  const int round = t >> 8, bid = t & 255, x = bid & 7, j = bid >> 3;
  if (lg == 2) { tm = round * 64 + x * 8 + (j >> 2); tn = j & 3; }
  else if (lg == 3) { tm = round * 32 + x * 4 + (j >> 3); tn = j & 7; }
  else { tm = round * 16 + (x >> 1) * 4 + (j >> 3); tn = (x & 1) * 8 + (j & 7); }
}

__device__ __forceinline__ void phase_gemm1(unsigned char* smem, const Params& P, int ctx_only) {
  const int lane = threadIdx.x & 63, wave = threadIdx.x >> 6, wm = wave >> 2, wn = wave & 3, r = lane & 15, q = lane >> 4;
  ABlk af{(const bf16_t*)(P.ws + OFF_A1), 34816};
  const bf16_t* W = (const bf16_t*)(P.ws + OFF_WTIN);
  bf16_t* A2 = (bf16_t*)(P.ws + OFF_A2);
  bf16_t* Z = (bf16_t*)(P.ws + OFF_Z);
  unsigned char* stg = smem + wave * 9216;
  for (int t = ctx_only ? 1024 + (int)blockIdx.x : (int)blockIdx.x; t < (ctx_only ? 1040 : 1024); t += gridDim.x) {
    int tm, tn;
    if (t < 1024) tile_map(t, 3, tm, tn); else { tm = 128 + ((t - 1024) >> 1); tn = t & 1; }
    f32x4 acc[8][4];
    gemm_tile(smem, af, W, 2048, 16, tm * 256, tn * 256, 34816, acc);
    if (tn < 2) {
#pragma unroll
      for (int half = 0; half < 2; ++half) {
#pragma unroll
        for (int mt = 0; mt < 4; ++mt) {
#pragma unroll
          for (int nt = 0; nt < 4; ++nt) {
            f32x4 a = acc[half * 4 + mt][nt];
            uint2 pk; pk.x = pack2(a[0], a[1]); pk.y = pack2(a[2], a[3]);
            *(uint2*)(stg + ((mt * 4 + nt) * 16 + r) * 32 + q * 8) = pk;
          }
        }
        __builtin_amdgcn_sched_barrier(0);
        const int mbase = tm * 256 + wm * 128 + half * 64;
        int rowbase;
        if (mbase < 32768) rowbase = (mbase >> 12) * 256 + ((mbase & 4095) >> 4);
        else { int mc = mbase - 32768; rowbase = 2048 + (mc >> 8) * 16 + ((mc & 255) >> 4); }
        const int g0 = (tn * 256 + wn * 64) >> 4;
#pragma unroll
        for (int i = 0; i < 8; ++i) {
          const int blk = i * 2 + (lane >> 5);
          const int mt = blk >> 2, nt = blk & 3;
          uint4 v = *(const uint4*)(stg + blk * 512 + (lane & 31) * 16);
          *(uint4*)(A2 + ((size_t)((g0 + nt) * 2176 + rowbase + mt)) * 512 + (lane & 31) * 8) = v;
        }
        __builtin_amdgcn_sched_barrier(0);
      }
    } else {
      const int cz0 = tn * 256 + wn * 64 - 512;
#pragma unroll
      for (int half = 0; half < 2; ++half) {
#pragma unroll
        for (int mt = 0; mt < 4; ++mt) {
#pragma unroll
          for (int nt = 0; nt < 4; ++nt) {
            f32x4 a = acc[half * 4 + mt][nt];
#pragma unroll
            for (int jj = 0; jj < 4; ++jj)
              *(bf16_t*)(stg + (nt * 16 + 4 * q + jj) * 144 + (mt * 16 + r) * 2) = f2bf(a[jj]);
          }
        }
        __builtin_amdgcn_sched_barrier(0);
        const int mbase = tm * 256 + wm * 128 + half * 64;
        const int b = mbase >> 12, l0 = mbase & 4095;
#pragma unroll
        for (int i = 0; i < 8; ++i) {
          int row = i * 8 + (lane >> 3), chunk = lane & 7;
          uint4 v = *(const uint4*)(stg + row * 144 + chunk * 16);
          *(uint4*)(Z + ((size_t)((cz0 + row) * 8 + b)) * 4096 + l0 + chunk * 8) = v;
        }
        __builtin_amdgcn_sched_barrier(0);
      }
    }
    __syncthreads();
  }
}

__device__ void phase_s5g1(unsigned char* smem, const Params& P) {
  const int lane = threadIdx.x & 63, wave = threadIdx.x >> 6, wm = wave >> 2, wn = wave & 3, r = lane & 15, q = lane >> 4;
  float* Sloc = (float*)(P.ws + OFF_SLOC);
  for (int t = blockIdx.x; t < 288; t += gridDim.x) {
    int g = t / 9, tm = t % 9, tn = 0;
    ALin af{(const bf16_t*)(P.ws + OFF_A2) + (size_t)g * 2176 * 512, 512};
    const bf16_t* W = (const bf16_t*)(P.ws + OFF_S5WIN) + (size_t)g * 65536;
    f32x4 acc[8][4];
    gemm_tile(smem, af, W, 256, 4, tm * 256, tn * 256, 2176, acc);
#pragma unroll
    for (int mt = 0; mt < 8; ++mt) {
      int m = tm * 256 + wm * 128 + mt * 16 + r;
      if (m < 2176) {
#pragma unroll
        for (int nt = 0; nt < 4; ++nt) {
          int n = tn * 256 + wn * 64 + nt * 16 + 4 * q;
          f32x4 a = acc[mt][nt];
          *(float4*)(Sloc + ((size_t)(g * 2176 + m)) * 256 + n) = make_float4(a[0], a[1], a[2], a[3]);
        }
      }
    }
  }
}

__device__ void phase_s5scan(const Params& P) {
  const float* a_re = P.in[8]; const float* a_im = P.in[9]; const float* lstep = P.in[10];
  if (threadIdx.x >= 128) return;
  for (int idx = blockIdx.x * 128 + threadIdx.x; idx < 32768; idx += gridDim.x * 128) {
    int p = idx & 63, b = (idx >> 6) & 7, d = (idx >> 9) & 1, g = idx >> 10;
    float are = a_re[(d * 32 + g) * 64 + p], aim = a_im[(d * 32 + g) * 64 + p];
    float step = __expf(lstep[d * 32 + g]);
    float mag = __expf(are * step * 16.0f), ang = aim * step * 16.0f;
    float lr_ = mag * hcos(ang), li_ = mag * hsin(ang);
    const float* sl = (const float*)(P.ws + OFF_SLOC) + (size_t)g * 2176 * 256 + d * 128 + 2 * p;
    bf16_t* dst = (bf16_t*)(P.ws + OFF_A2) + (size_t)g * 2176 * 512 + 256 + d * 128 + 2 * p;
    float sr = 0.f, si = 0.f;
    float2 xs[16];
#pragma unroll
    for (int cc = 0; cc < 16; ++cc) {
      int ci = d == 0 ? cc : 15 - cc;
      xs[cc] = *(const float2*)(sl + (size_t)(2048 + b * 16 + ci) * 256);
    }
#pragma unroll
    for (int cc = 0; cc < 16; ++cc) {
      float nr = lr_ * sr - li_ * si + xs[cc].x, ni = lr_ * si + li_ * sr + xs[cc].y;
      sr = nr; si = ni;
    }
#pragma unroll 1
    for (int c0 = 0; c0 < 256; c0 += 16) {
#pragma unroll
      for (int cc = 0; cc < 16; ++cc) {
        int c = c0 + cc;
        int ci = d == 0 ? c : 255 - c;
        xs[cc] = *(const float2*)(sl + (size_t)(b * 256 + ci) * 256);
      }
#pragma unroll
      for (int cc = 0; cc < 16; ++cc) {
        int c = c0 + cc;
        int ci = d == 0 ? c : 255 - c;
        *(unsigned*)(dst + (size_t)(b * 256 + ci) * 512) = pack2(sr, si);
        float nr = lr_ * sr - li_ * si + xs[cc].x, ni = lr_ * si + li_ * sr + xs[cc].y;
        sr = nr; si = ni;
      }
    }
  }
}

__device__ void phase_s5g2(unsigned char* smem, const Params& P) {
  const int lane = threadIdx.x & 63, wave = threadIdx.x >> 6, wm = wave >> 2, wn = wave & 3, r = lane & 15, q = lane >> 4;
  bf16_t* Y = (bf16_t*)(P.ws + OFF_YS5G);
  for (int t = blockIdx.x; t < 256; t += gridDim.x) {
    int g = t >> 3, tm = t & 7, tn = 0;
    ALin af{(const bf16_t*)(P.ws + OFF_A2) + (size_t)g * 2176 * 512, 512};
    const bf16_t* W = (const bf16_t*)(P.ws + OFF_S5WCAT) + (size_t)g * 131072;
    f32x4 acc[8][4];
    gemm_tile(smem, af, W, 256, 8, tm * 256, tn * 256, 2048, acc);
#pragma unroll
    for (int mt = 0; mt < 8; ++mt) {
      int m = tm * 256 + wm * 128 + mt * 16 + r;
#pragma unroll
      for (int nt = 0; nt < 4; ++nt) {
        int n = tn * 256 + wn * 64 + nt * 16 + 4 * q;
        f32x4 a = acc[mt][nt];
        uint2 pk; pk.x = pack2(gelu_tanh(a[0]), gelu_tanh(a[1])); pk.y = pack2(gelu_tanh(a[2]), gelu_tanh(a[3]));
        {
          const int token = m * 16 + (n >> 4), ch = n & 15;
          *(uint2*)(Y + ((size_t)(g >> 1) * 32768 + token) * 32 + (g & 1) * 16 + ch) = pk;
        }
      }
    }
  }
}

__device__ void phase_glu(unsigned char* smem, const Params& P) {
  const int lane = threadIdx.x & 63, wave = threadIdx.x >> 6, wm = wave >> 2, wn = wave & 3, r = lane & 15, q = lane >> 4;
  ABlk af{(const bf16_t*)(P.ws + OFF_YS5G), 32768};
  const bf16_t* W = (const bf16_t*)(P.ws + OFF_WTGLU);
  const float* bias = P.in[17];
  bf16_t* Y = (bf16_t*)(P.ws + OFF_YS5);
  for (int t = blockIdx.x; t < 512; t += gridDim.x) {
    int tm, tn; tile_map(t, 2, tm, tn);
    f32x4 acc[8][4];
    gemm_tile(smem, af, W, 1024, 8, tm * 256, tn * 256, 32768, acc);
    const int qq = (tn * 256 + wn * 64) >> 6;
#pragma unroll
    for (int mt = 0; mt < 8; ++mt) {
      int m = tm * 256 + wm * 128 + mt * 16 + r;
#pragma unroll
      for (int nt = 0; nt < 2; ++nt) {
        int f = 32 * qq + 16 * nt + 4 * q;
        float4 bv = *(const float4*)(bias + f), bg = *(const float4*)(bias + 512 + f);
        f32x4 va = acc[mt][nt], ga = acc[mt][nt + 2];
        float y0 = (va[0] + bv.x) / (1.0f + __expf(-(ga[0] + bg.x)));
        float y1 = (va[1] + bv.y) / (1.0f + __expf(-(ga[1] + bg.y)));
        float y2 = (va[2] + bv.z) / (1.0f + __expf(-(ga[2] + bg.z)));
        float y3 = (va[3] + bv.w) / (1.0f + __expf(-(ga[3] + bg.w)));
        uint2 pk; pk.x = pack2(y0, y1); pk.y = pack2(y2, y3);
        *(uint2*)(Y + (size_t)m * 512 + f) = pk;
      }
    }
  }
}

__device__ void phase_wout(unsigned char* smem, const Params& P) {
  const int lane = threadIdx.x & 63, wave = threadIdx.x >> 6, wm = wave >> 2, wn = wave & 3, r = lane & 15, q = lane >> 4;
  ABlk af{(const bf16_t*)(P.ws + OFF_A1), 34816};
  const bf16_t* W = (const bf16_t*)(P.ws + OFF_WTOUT);
  const float* mod = (const float*)(P.ws + OFF_MOD);
  const float* E = (const float*)(P.ws + OFF_POS);
  const float* x = P.in[0];
  for (int t = blockIdx.x; t < 512; t += gridDim.x) {
    int tm, tn; tile_map(t, 2, tm, tn);
    f32x4 acc[8][4];
    gemm_tile(smem, af, W, 1024, 16, tm * 256, tn * 256, 32768, acc);
    const int b = (tm * 256) >> 12;
    const int nb = tn * 256 + wn * 64 + 4 * q;
#pragma unroll
    for (int mt = 0; mt < 8; ++mt) {
      const int m = tm * 256 + wm * 128 + mt * 16 + r;
      const int l = m & 4095;
      float4 xv[4], ev[4];
#pragma unroll
      for (int nt = 0; nt < 4; ++nt) {
        int n = nb + nt * 16;
        xv[nt] = *(const float4*)(x + (size_t)m * 1024 + n);
        ev[nt] = n < 512 ? *(const float4*)(E + (l >> 6) * 512 + n) : *(const float4*)(E + (l & 63) * 512 + n - 512);
      }
      __builtin_amdgcn_sched_barrier(0);
#pragma unroll
      for (int nt = 0; nt < 4; ++nt) {
        int n = nb + nt * 16;
        f32x4 a = acc[mt][nt];
        float4 gt = *(const float4*)(mod + b * 6144 + 2048 + n);
        float4 o;
        o.x = xv[nt].x + ev[nt].x + gt.x * a[0]; o.y = xv[nt].y + ev[nt].y + gt.y * a[1];
        o.z = xv[nt].z + ev[nt].z + gt.z * a[2]; o.w = xv[nt].w + ev[nt].w + gt.w * a[3];
        *(float4*)(P.out + (size_t)m * 1024 + n) = o;
      }
      __builtin_amdgcn_sched_barrier(0);
    }
  }
}

__device__ void phase_mlp1(unsigned char* smem, const Params& P) {
  const int lane = threadIdx.x & 63, wave = threadIdx.x >> 6, wm = wave >> 2, wn = wave & 3, r = lane & 15, q = lane >> 4;
  ABlk af{(const bf16_t*)(P.ws + OFF_A1), 34816};
  const bf16_t* W = (const bf16_t*)(P.ws + OFF_WT1);
  bf16_t* hid = (bf16_t*)(P.ws + OFF_HID);
  unsigned char* stg = smem + wave * 9216;
  for (int t = blockIdx.x; t < 2048; t += gridDim.x) {
    int tm, tn; tile_map(t, 4, tm, tn);
    f32x4 acc[8][4];
    gemm_tile(smem, af, W, 4096, 16, tm * 256, tn * 256, 32768, acc);
#pragma unroll
    for (int half = 0; half < 2; ++half) {
#pragma unroll
      for (int mt = 0; mt < 4; ++mt) {
#pragma unroll
        for (int nt = 0; nt < 4; ++nt) {
          f32x4 a = acc[half * 4 + mt][nt];
          float r0 = fmaxf(a[0], 0.f), r1 = fmaxf(a[1], 0.f), r2 = fmaxf(a[2], 0.f), r3 = fmaxf(a[3], 0.f);
          uint2 pk; pk.x = pack2(r0 * r0, r1 * r1); pk.y = pack2(r2 * r2, r3 * r3);
          *(uint2*)(stg + (mt * 16 + r) * 144 + (nt * 16 + 4 * q) * 2) = pk;
        }
      }
      __builtin_amdgcn_sched_barrier(0);
#pragma unroll
      for (int i = 0; i < 8; ++i) {
        int row = i * 8 + (lane >> 3), chunk = lane & 7;
        uint4 v = *(const uint4*)(stg + row * 144 + chunk * 16);
        int m = tm * 256 + wm * 128 + half * 64 + row;
        *(uint4*)(hid + ((size_t)(tn * 8 + wn * 2 + (chunk >> 2)) * 32768 + m) * 32 + (chunk & 3) * 8) = v;
      }
      __builtin_amdgcn_sched_barrier(0);
    }
    __syncthreads();
  }
}

__device__ void phase_mlp2(unsigned char* smem, const Params& P) {
  const int lane = threadIdx.x & 63, wave = threadIdx.x >> 6, wm = wave >> 2, wn = wave & 3, r = lane & 15, q = lane >> 4;
  ABlk af{(const bf16_t*)(P.ws + OFF_HID), 32768};
  const bf16_t* W = (const bf16_t*)(P.ws + OFF_WT2);
  const float* mod = (const float*)(P.ws + OFF_MOD);
  for (int t = blockIdx.x; t < 512; t += gridDim.x) {
    int tm, tn; tile_map(t, 2, tm, tn);
    f32x4 acc[8][4];
    gemm_tile(smem, af, W, 1024, 64, tm * 256, tn * 256, 32768, acc);
    const int b = (tm * 256) >> 12;
    const int nb = tn * 256 + wn * 64 + 4 * q;
    float4 gt[4];
#pragma unroll
    for (int nt = 0; nt < 4; ++nt) gt[nt] = *(const float4*)(mod + b * 6144 + 5120 + nb + nt * 16);
#pragma unroll
    for (int mp = 0; mp < 4; ++mp) {
      float4 o[2][4];
#pragma unroll
      for (int h = 0; h < 2; ++h)
#pragma unroll
        for (int nt = 0; nt < 4; ++nt) {
          int m = tm * 256 + wm * 128 + (mp * 2 + h) * 16 + r;
          o[h][nt] = *(const float4*)(P.out + (size_t)m * 1024 + nb + nt * 16);
        }
      __builtin_amdgcn_sched_barrier(0);
#pragma unroll
      for (int h = 0; h < 2; ++h)
#pragma unroll
        for (int nt = 0; nt < 4; ++nt) {
          int m = tm * 256 + wm * 128 + (mp * 2 + h) * 16 + r;
          f32x4 a = acc[mp * 2 + h][nt];
          float4 v = o[h][nt];
          v.x += gt[nt].x * a[0]; v.y += gt[nt].y * a[1]; v.z += gt[nt].z * a[2]; v.w += gt[nt].w * a[3];
          *(float4*)(P.out + (size_t)m * 1024 + nb + nt * 16) = v;
        }
      __builtin_amdgcn_sched_barrier(0);
    }
  }
}

__device__ void phase_mixnorm(unsigned char* smem, const Params& P) {
  const int tid = threadIdx.x, lane = tid & 63, wave = tid >> 6;
  bf16_t* hyT = (bf16_t*)smem;
  const bf16_t* Z = (const bf16_t*)(P.ws + OFF_Z);
  const bf16_t* Ys5 = (const bf16_t*)(P.ws + OFF_YS5);
  bf16_t* mix = (bf16_t*)(P.ws + OFF_A1);
  for (int tile = blockIdx.x; tile < 512; tile += gridDim.x) {
    int b = tile >> 6, l0 = (tile & 63) * 64;
    {
      const uint4* src = (const uint4*)(Z + ((size_t)(tid * 8 + b)) * 4096 + l0);
      unsigned* drow = (unsigned*)(hyT + tid * 66);
#pragma unroll
      for (int i = 0; i < 8; ++i) {
        uint4 v = src[i];
        drow[i * 4 + 0] = v.x; drow[i * 4 + 1] = v.y; drow[i * 4 + 2] = v.z; drow[i * 4 + 3] = v.w;
      }
    }
    __syncthreads();
#pragma unroll 1
    for (int hh = 0; hh < 2; ++hh) {
      uint4 svp[4];
#pragma unroll
      for (int i = 0; i < 4; ++i) svp[i] = *(const uint4*)(Ys5 + ((size_t)b * 4096 + l0 + wave * 8 + hh * 4 + i) * 512 + lane * 8);
#pragma unroll
      for (int ti = 0; ti < 4; ++ti) {
        const int tt = wave * 8 + hh * 4 + ti;
        size_t token = (size_t)b * 4096 + l0 + tt;
      uint4 sv = svp[ti];
      float s[8];
      s[0] = bf2f(sv.x & 0xffff); s[1] = bf2f(sv.x >> 16); s[2] = bf2f(sv.y & 0xffff); s[3] = bf2f(sv.y >> 16);
      s[4] = bf2f(sv.z & 0xffff); s[5] = bf2f(sv.z >> 16); s[6] = bf2f(sv.w & 0xffff); s[7] = bf2f(sv.w >> 16);
      float h[8];
      float ss5 = 0.f, ssh = 0.f;
#pragma unroll
      for (int i = 0; i < 8; ++i) {
        h[i] = bf2f(hyT[(lane + 64 * i) * 66 + tt]);
        ss5 += s[i] * s[i]; ssh += h[i] * h[i];
      }
      ss5 = wave_sum(ss5); ssh = wave_sum(ssh);
      float r5 = rsqrtf(ss5 * (1.0f / 512.0f) + 1e-6f), rh = rsqrtf(ssh * (1.0f / 512.0f) + 1e-6f);
      uint4 o;
      o.x = pack2(s[0] * r5, s[1] * r5); o.y = pack2(s[2] * r5, s[3] * r5);
      o.z = pack2(s[4] * r5, s[5] * r5); o.w = pack2(s[6] * r5, s[7] * r5);
      *(uint4*)(mix + ((size_t)(lane >> 2) * 34816 + token) * 32 + (lane & 3) * 8) = o;
#pragma unroll
      for (int i = 0; i < 8; ++i) mix[((size_t)(16 + 2 * i + (lane >> 5)) * 34816 + token) * 32 + (lane & 31)] = f2bf(h[i] * rh);
          }
    }
    __syncthreads();
  }
}

__device__ __forceinline__ constexpr int SW(int i) { return i ^ ((i >> 3) & 31); }
#define DSW(PTR, TYPE, SWB8, C) (*(TYPE*)((unsigned char*)(PTR) + ((SWB8) ^ (SW(C) << 3))))

typedef float v2f __attribute__((ext_vector_type(2)));
#define C16(k) (C16_TAB[(k) & 15])
#define S16(k) (S16_TAB[(k) & 15])
__device__ constexpr float C16_TAB[16] = {1.000000000e+00f, 9.238795325e-01f, 7.071067812e-01f, 3.826834324e-01f, 6.123233996e-17f, -3.826834324e-01f, -7.071067812e-01f, -9.238795325e-01f, -1.000000000e+00f, -9.238795325e-01f, -7.071067812e-01f, -3.826834324e-01f, -1.836970199e-16f, 3.826834324e-01f, 7.071067812e-01f, 9.238795325e-01f};
__device__ constexpr float S16_TAB[16] = {0.000000000e+00f, 3.826834324e-01f, 7.071067812e-01f, 9.238795325e-01f, 1.000000000e+00f, 9.238795325e-01f, 7.071067812e-01f, 3.826834324e-01f, 1.224646799e-16f, -3.826834324e-01f, -7.071067812e-01f, -9.238795325e-01f, -1.000000000e+00f, -9.238795325e-01f, -7.071067812e-01f, -3.826834324e-01f};

struct TwBase { float c[4], s[4]; };
template <int S0>
__device__ __forceinline__ TwBase make_twbase(int lo) {
  TwBase t;
  float rev = (float)lo * (1.0f / (float)(1 << (13 - S0)));
  t.c[0] = cosrev(rev); t.s[0] = sinrev(rev);
#pragma unroll
  for (int u = 1; u < 4; ++u) { t.c[u] = t.c[u - 1] * t.c[u - 1] - t.s[u - 1] * t.s[u - 1]; t.s[u] = 2.0f * t.c[u - 1] * t.s[u - 1]; }
  return t;
}
template <int NS, int S0, bool INV, bool TOKS = false>
__device__ __forceinline__ void fft_pass(float2* Df, int tid0, float2* KSout = nullptr, const TwBase* twb = nullptr) {
  v2f* D = (v2f*)Df;
  constexpr int R = 1 << NS;
  constexpr int pos = 13 - S0 - NS;
#pragma unroll 1
  for (int tix = tid0; tix < (8192 >> NS); tix += NT) {
    const int lo = tix & ((1 << pos) - 1), hi = tix >> pos;
    const int base = (hi << (pos + NS)) | lo;
    v2f v[R];
    const int swb8 = SW(base) << 3;
#pragma unroll
    for (int e = 0; e < R; ++e) v[e] = DSW(D, v2f, swb8, e << pos);
    float tc[NS], ts[NS];
    if (twb) {
#pragma unroll
      for (int u = 0; u < NS; ++u) { tc[u] = twb->c[u]; ts[u] = twb->s[u]; asm volatile("" : "+v"(tc[u]), "+v"(ts[u])); }
    } else {
      float rev = (float)lo * (1.0f / (float)(1 << (13 - S0)));
      tc[0] = cosrev(rev); ts[0] = sinrev(rev);
#pragma unroll
      for (int u = 1; u < NS; ++u) { tc[u] = tc[u - 1] * tc[u - 1] - ts[u - 1] * ts[u - 1]; ts[u] = 2.0f * tc[u - 1] * ts[u - 1]; }
    }
    if (!INV) {
#pragma unroll
      for (int u = 0; u < NS; ++u) {
        const int bit = 1 << (NS - 1 - u);
#pragma unroll
        for (int e = 0; e < R; ++e) {
          if (e & bit) continue;
          const int k16 = (e & (bit - 1)) << (4 - NS + u);
          float c, sn;
          if (k16 == 0) { c = tc[u]; sn = ts[u]; }
          else if (k16 == 4) { c = -ts[u]; sn = tc[u]; }
          else { c = tc[u] * C16(k16) - ts[u] * S16(k16); sn = ts[u] * C16(k16) + tc[u] * S16(k16); }
          v2f a = v[e], bb = v[e | bit];
          v2f d = a - bb;
          v[e] = a + bb;
          v2f t1 = d * (v2f){c, c};
          v[e | bit] = __builtin_elementwise_fma((v2f){d.y, d.x}, (v2f){sn, -sn}, t1);
        }
      }
    } else {
#pragma unroll
      for (int u = NS - 1; u >= 0; --u) {
        const int bit = 1 << (NS - 1 - u);
#pragma unroll
        for (int e = 0; e < R; ++e) {
          if (e & bit) continue;
          const int k16 = (e & (bit - 1)) << (4 - NS + u);
          float c, sn;
          if (k16 == 0) { c = tc[u]; sn = ts[u]; }
          else if (k16 == 4) { c = -ts[u]; sn = tc[u]; }
          else { c = tc[u] * C16(k16) - ts[u] * S16(k16); sn = ts[u] * C16(k16) + tc[u] * S16(k16); }
          v2f a = v[e], bb = v[e | bit];
          v2f t1 = bb * (v2f){c, c};
          v2f t = __builtin_elementwise_fma((v2f){bb.y, bb.x}, (v2f){-sn, sn}, t1);
          v[e] = a + t;
          v[e | bit] = a - t;
        }
      }
    }
#pragma unroll
    for (int e = 0; e < R; ++e) {
      if (TOKS) DSW(KSout, v2f, swb8, e << pos) = v[e] * (v2f){1.0f / 8192.0f, 1.0f / 8192.0f};
      else DSW(D, v2f, swb8, e << pos) = v[e];
    }
  }
}

__device__ __forceinline__ int opaque_tid_fwd() {
  int t = threadIdx.x;
  asm volatile("" : "+v"(t));
  return t;
}
__device__ __forceinline__ void fft_mid(float2* Df, const float2* KSf, int tid0) {
  v2f* D = (v2f*)Df;
  const v2f* KS = (const v2f*)KSf;
  const int base = tid0 << 4;
  v2f v[16];
  const int swb8 = SW(base) << 3;
#pragma unroll
  for (int e = 0; e < 16; ++e) v[e] = DSW(D, v2f, swb8, e);
#pragma unroll
  for (int u = 0; u < 4; ++u) {
    const int bit = 1 << (3 - u);
    const float scale = 1.0f / (float)(1 << (4 - u));
#pragma unroll
    for (int e = 0; e < 16; ++e) {
      if (e & bit) continue;
      const int k16 = (e & (bit - 1)) << u;
      const float c = C16(k16), sn = S16(k16);
      v2f a = v[e], bb = v[e | bit];
      v2f d = a - bb;
      v[e] = a + bb;
      if (k16 == 0) v[e | bit] = d;
      else if (k16 == 4) v[e | bit] = (v2f){d.y, -d.x};
      else {
        v2f t1 = d * (v2f){c, c};
        v[e | bit] = __builtin_elementwise_fma((v2f){d.y, d.x}, (v2f){sn, -sn}, t1);
      }
    }
  }
#pragma unroll
  for (int e = 0; e < 16; ++e) {
    v2f k = DSW(KS, const v2f, swb8, e);
    v2f a = v[e];
    v2f t1 = a * (v2f){k.x, k.x};
    v[e] = __builtin_elementwise_fma((v2f){a.y, a.x}, (v2f){-k.y, k.y}, t1);
  }
#pragma unroll
  for (int u = 3; u >= 0; --u) {
    const int bit = 1 << (3 - u);
    const float scale = 1.0f / (float)(1 << (4 - u));
#pragma unroll
    for (int e = 0; e < 16; ++e) {
      if (e & bit) continue;
      const int k16 = (e & (bit - 1)) << u;
      const float c = C16(k16), sn = S16(k16);
      v2f a = v[e], bb = v[e | bit];
      v2f t;
      if (k16 == 0) t = bb;
      else if (k16 == 4) t = (v2f){-bb.y, bb.x};
      else {
        v2f t1 = bb * (v2f){c, c};
        t = __builtin_elementwise_fma((v2f){bb.y, bb.x}, (v2f){-sn, sn}, t1);
      }
      v[e] = a + t;
      v[e | bit] = a - t;
    }
  }
#pragma unroll
  for (int e = 0; e < 16; ++e) DSW(D, v2f, swb8, e) = v[e];
}
__device__ __forceinline__ int opaque_tid() {
  int t = threadIdx.x;
  asm volatile("" : "+v"(t));
  return t;
}
__device__ __forceinline__ void fft_conv(float2* D, const float2* KS, const TwBase& tw1, const TwBase& tw5) {
  const int t = opaque_tid();
  fft_pass<4, 1, false>(D, t, nullptr, &tw1); __syncthreads();
  fft_pass<4, 5, false>(D, t, nullptr, &tw5); __syncthreads();
  fft_mid(D, KS, t); __syncthreads();
  fft_pass<4, 5, true>(D, t, nullptr, &tw5); __syncthreads();
  fft_pass<4, 1, true>(D, t, nullptr, &tw1); __syncthreads();
}
__device__ __forceinline__ void fft_fwd(float2* D, float2* KS, const TwBase& tw1, const TwBase& tw5) {
  const int t = opaque_tid();
  fft_pass<4, 1, false>(D, t, nullptr, &tw1); __syncthreads();
  fft_pass<4, 5, false>(D, t, nullptr, &tw5); __syncthreads();
  fft_pass<4, 9, false, true>(D, t, KS); __syncthreads();
}

#define LOAD8(X, ROW, T)                                                          \
  float X##0, X##1, X##2, X##3, X##4, X##5, X##6, X##7, X##8, X##9;               \
  {                                                                               \
    const bf16_t* rw_ = (ROW);                                                    \
    uint4 v_ = *(const uint4*)(rw_ + 8 * (T));                                    \
    X##0 = (T) > 0 ? bf2f(rw_[8 * (T)-1]) : 0.f;                                  \
    X##9 = (T) < 511 ? bf2f(rw_[8 * (T) + 8]) : 0.f;                              \
    X##1 = bf2f(v_.x & 0xffff); X##2 = bf2f(v_.x >> 16);                          \
    X##3 = bf2f(v_.y & 0xffff); X##4 = bf2f(v_.y >> 16);                          \
    X##5 = bf2f(v_.z & 0xffff); X##6 = bf2f(v_.z >> 16);                          \
    X##7 = bf2f(v_.w & 0xffff); X##8 = bf2f(v_.w >> 16);                          \
  }
#define SC3(XM, X0, XP, W0, W1, W2, B) ((XM) * (W0) + (X0) * (W1) + (XP) * (W2) + (B))

#define LD_ST(E, XM, X0, XP, YM, Y0, YP)                                                   \
          {                                                                               \
            float a0_ = SC3(XM, X0, XP, ua, ub, uc, ud), a1_ = SC3(YM, Y0, YP, ua, ub, uc, ud); \
            float rv_ = (float)(i0 + (E)) * (1.0f / 8192.0f);                             \
            float c_ = cosrev(rv_), s_ = sinrev(rv_);                                     \
            DSW(D, float2, sw0, (E)) = make_float2(a0_, a1_);                                \
            DSW(D + 4096, float2, sw0, (E)) = make_float2(a0_ * c_ + a1_ * s_, a1_ * c_ - a0_ * s_); \
          }
#define RD_Y(E)                                                                           \
          float2 y##E;                                                                    \
          {                                                                               \
            float2 A_ = DSW(D, float2, sw0, (E)), B_ = DSW(D + 4096, float2, sw0, (E));     \
            float rv_ = (float)(i0 + (E)) * (1.0f / 8192.0f);                             \
            float c_ = cosrev(rv_), s_ = sinrev(rv_);                                     \
            y##E = make_float2(A_.x + B_.x * c_ - B_.y * s_, A_.y + B_.x * s_ + B_.y * c_); \
          }
#define OUTA(E, XM, X0, XP, GM, G0, GP) (SC3(GM, G0, GP, wg0, wg1, wg2, bg) * (y##E.x + bias * SC3(XM, X0, XP, ua, ub, uc, ud)))
#define OUTB(E, XM, X0, XP, GM, G0, GP) (SC3(GM, G0, GP, wg0, wg1, wg2, bg) * (y##E.y + bias * SC3(XM, X0, XP, ua, ub, uc, ud)))
__device__ void phase_hyena(unsigned char* smem, const Params& P) {
  const int tid = threadIdx.x;
  float2* D = (float2*)smem;
  float2* KS = D + 8192;
  bf16_t* Z = (bf16_t*)(P.ws + OFF_Z);
  bf16_t* Z1 = (bf16_t*)(P.ws + OFF_Z1);
  const float* filt = (const float*)(P.ws + OFF_FILT);
  const float* cw = P.in[18]; const float* cb = P.in[19]; const float* hbias = P.in[27];
  const TwBase tw1 = make_twbase<1>(tid & 255), tw5 = make_twbase<5>(tid & 15);
#pragma unroll 1
  for (int c = blockIdx.x; c < 512; c += gridDim.x) {
    bf16_t* Zv = Z + (size_t)c * 8 * 4096;
    bf16_t* Zm = Z1 + (size_t)c * 8 * 4096;
    const float wv0 = cw[c], wv1 = cw[1536 + c], wv2 = cw[3072 + c], bv = cb[c];
#pragma unroll 1
    for (int order = 0; order < 2; ++order) {
      const float* hf = filt + ((size_t)((order * 2 + 0) * 512 + c)) * 4096;
      const float* hb = filt + ((size_t)((order * 2 + 1) * 512 + c)) * 4096;
#pragma unroll 2
      for (int i = tid; i < 4096; i += NT) {
        const float lo_v = hf[i];
        const float up_v = i == 0 ? 0.f : hb[4096 - i];
        const float a = lo_v + up_v, d = lo_v - up_v;
        const float rv = (float)i * (1.0f / 8192.0f);
        D[SW(i)] = make_float2(a, 0.f);
        D[SW(i + 4096)] = make_float2(d * cosrev(rv), -d * sinrev(rv));
      }
      __syncthreads();
      fft_fwd(D, KS, tw1, tw5);
      const int cgi = (order == 0 ? 512 : 1024) + c;
      const bf16_t* Zg = Z + (size_t)cgi * 8 * 4096;
      const float wg0 = cw[cgi], wg1 = cw[1536 + cgi], wg2 = cw[3072 + cgi], bg = cb[cgi];
      const float bias = hbias[order * 512 + c];
      const float ua = order == 0 ? wv0 : 0.f, ub = order == 0 ? wv1 : 1.f, uc = order == 0 ? wv2 : 0.f, ud = order == 0 ? bv : 0.f;
#define RAW_LOAD(R, ROW, T)                                              \
      {                                                                      \
        const bf16_t* rw_ = (ROW);                                           \
        R##v = *(const uint4*)(rw_ + 8 * (T));                               \
        R##p = (T) > 0 ? rw_[8 * (T)-1] : (bf16_t)0;                         \
        R##n = (T) < 511 ? rw_[8 * (T) + 8] : (bf16_t)0;                     \
      }
#define RAW_UNPACK(X, R)                                                     \
      const float X##0 = bf2f(R##p), X##9 = bf2f(R##n),                      \
                  X##1 = bf2f(R##v.x & 0xffff), X##2 = bf2f(R##v.x >> 16),   \
                  X##3 = bf2f(R##v.y & 0xffff), X##4 = bf2f(R##v.y >> 16),   \
                  X##5 = bf2f(R##v.z & 0xffff), X##6 = bf2f(R##v.z >> 16),   \
                  X##7 = bf2f(R##v.w & 0xffff), X##8 = bf2f(R##v.w >> 16);
      const bf16_t* rin = (order == 0 ? Zv : Zm);
      uint4 rav, rbv, rgv, rhv; bf16_t rap, ran, rbp, rbn, rgp, rgn, rhp, rhn;
      RAW_LOAD(ra, rin, tid)
      RAW_LOAD(rb, rin + 4096, tid)
#pragma unroll 1
      for (int pair = 0; pair < 4; ++pair) {
        const uint4 sav = rav, sbv = rbv; const bf16_t sap = rap, san = ran, sbp = rbp, sbn = rbn;
        {
          RAW_UNPACK(xa, ra)
          RAW_UNPACK(xb, rb)
          int i0 = 8 * tid;
          asm volatile("" : "+v"(i0));
          const int sw0 = SW(i0) << 3;
          LD_ST(0, xa0, xa1, xa2, xb0, xb1, xb2)
          LD_ST(1, xa1, xa2, xa3, xb1, xb2, xb3)
          LD_ST(2, xa2, xa3, xa4, xb2, xb3, xb4)
          LD_ST(3, xa3, xa4, xa5, xb3, xb4, xb5)
          LD_ST(4, xa4, xa5, xa6, xb4, xb5, xb6)
          LD_ST(5, xa5, xa6, xa7, xb5, xb6, xb7)
          LD_ST(6, xa6, xa7, xa8, xb6, xb7, xb8)
          LD_ST(7, xa7, xa8, xa9, xb7, xb8, xb9)
        }
        RAW_LOAD(rg, Zg + (size_t)(2 * pair) * 4096, tid)
        RAW_LOAD(rh, Zg + (size_t)(2 * pair + 1) * 4096, tid)
        {
          const int np = pair < 3 ? pair + 1 : pair;
          RAW_LOAD(ra, rin + (size_t)(2 * np) * 4096, tid)
          RAW_LOAD(rb, rin + (size_t)(2 * np + 1) * 4096, tid)
        }
        __syncthreads();
        fft_conv(D, KS, tw1, tw5);
        {
          bf16_t* o0 = (order == 0 ? Zm : Zv) + (size_t)(2 * pair) * 4096;
          bf16_t* o1 = o0 + 4096;
          RAW_UNPACK(ga, rg)
          RAW_UNPACK(gb, rh)
          RAW_UNPACK(xa, sa)
          RAW_UNPACK(xb, sb)
          int i0 = 8 * tid;
          asm volatile("" : "+v"(i0));
          const int sw0 = SW(i0) << 3;
          RD_Y(0) RD_Y(1) RD_Y(2) RD_Y(3) RD_Y(4) RD_Y(5) RD_Y(6) RD_Y(7)
          uint4 pa, pb;
          pa.x = pack2(OUTA(0, xa0, xa1, xa2, ga0, ga1, ga2), OUTA(1, xa1, xa2, xa3, ga1, ga2, ga3));
          pa.y = pack2(OUTA(2, xa2, xa3, xa4, ga2, ga3, ga4), OUTA(3, xa3, xa4, xa5, ga3, ga4, ga5));
          pa.z = pack2(OUTA(4, xa4, xa5, xa6, ga4, ga5, ga6), OUTA(5, xa5, xa6, xa7, ga5, ga6, ga7));
          pa.w = pack2(OUTA(6, xa6, xa7, xa8, ga6, ga7, ga8), OUTA(7, xa7, xa8, xa9, ga7, ga8, ga9));
          pb.x = pack2(OUTB(0, xb0, xb1, xb2, gb0, gb1, gb2), OUTB(1, xb1, xb2, xb3, gb1, gb2, gb3));
          pb.y = pack2(OUTB(2, xb2, xb3, xb4, gb2, gb3, gb4), OUTB(3, xb3, xb4, xb5, gb3, gb4, gb5));
          pb.z = pack2(OUTB(4, xb4, xb5, xb6, gb4, gb5, gb6), OUTB(5, xb5, xb6, xb7, gb5, gb6, gb7));
          pb.w = pack2(OUTB(6, xb6, xb7, xb8, gb6, gb7, gb8), OUTB(7, xb7, xb8, xb9, gb7, gb8, gb9));
          *(uint4*)(o0 + i0) = pa;
          *(uint4*)(o1 + i0) = pb;
        }
        __syncthreads();
      }
    }
  }
}


#define XB_TMO      128
#define XB_XCNT(j)  (256  + 64 * (j))
#define XB_XSUB(j)  (1280 + 64 * (j))
#define XB_XGEN(j)  (2304 + 64 * (j))
#define XB_TOP      3328
#define XB_TOPGEN   3392
#define XCD_BAR_WORDS 3456
#define XB_SPIN_CAP (1u << 18)
#define LAS __attribute__((address_space(3)))
__device__ __forceinline__ unsigned xb_ld(unsigned* p) { return __hip_atomic_load(p, __ATOMIC_RELAXED, __HIP_MEMORY_SCOPE_AGENT); }
__device__ __forceinline__ unsigned xb_add(unsigned* p, unsigned v) { return __hip_atomic_fetch_add(p, v, __ATOMIC_RELAXED, __HIP_MEMORY_SCOPE_AGENT); }
__device__ __forceinline__ unsigned xb_xcc_id() { return (unsigned)__builtin_amdgcn_s_getreg((3 << 11) | 20) & 0xFu; }
#define XB_SPIN(cond, bar) do { unsigned _sp = 0; while (cond) { __builtin_amdgcn_s_sleep(1); \
    if ((++_sp & 255u) == 0u) { if (xb_ld(&(bar)[XB_TMO])) break; if (_sp > XB_SPIN_CAP) { atomicAdd(&(bar)[XB_TMO], 1u); break; } } } } while (0)
struct XcdBarrier { unsigned* bar; unsigned x; volatile LAS unsigned* st; };
__device__ __forceinline__ XcdBarrier xcd_barrier_post(unsigned* bar, volatile LAS unsigned* st) {
  XcdBarrier b; b.bar = bar; b.x = xb_xcc_id(); b.st = st;
  if (threadIdx.x == 0) (void)xb_add(&bar[XB_XCNT(b.x)], 1u);
  return b;
}
__device__ __forceinline__ void xcd_barrier_complete(unsigned* bar, unsigned x, unsigned& nloc, unsigned& nx) {
  const unsigned G = gridDim.x * gridDim.y * gridDim.z;
  unsigned sum, cnt, mine, sp = 0u;
  for (;;) {
    sum = 0u; cnt = 0u; mine = 0u;
#pragma unroll
    for (unsigned j = 0; j < 16; ++j) { const unsigned c = xb_ld(&bar[XB_XCNT(j)]); sum += c; cnt += (c > 0u) ? 1u : 0u; mine = (j == x) ? c : mine; }
    if (sum == G) break;
    __builtin_amdgcn_s_sleep(1);
    if ((++sp & 255u) == 0u) { if (xb_ld(&bar[XB_TMO])) break; if (sp > XB_SPIN_CAP) { atomicAdd(&bar[XB_TMO], 1u); break; } }
  }
  nloc = mine > 0u ? mine : 1u; nx = cnt > 0u ? cnt : 1u;
}
__device__ __forceinline__ void xcd_barrier(unsigned* bar_, volatile LAS unsigned* st_) {
  asm volatile("s_waitcnt vmcnt(0)" ::: "memory");
  __syncthreads();
  if (threadIdx.x == 0) {
    XcdBarrier b; b.bar = bar_; b.x = xb_xcc_id(); b.st = st_;
    unsigned* bar = b.bar;
    __builtin_amdgcn_s_waitcnt(0);
    unsigned nloc = b.st[0], nx = b.st[1];
    if (nloc == 0u) { xcd_barrier_complete(bar, b.x, nloc, nx); b.st[0] = nloc; b.st[1] = nx; }
    const unsigned old = xb_add(&bar[XB_XSUB(b.x)], 1u);
    const unsigned gen = old / nloc;
    if (old + 1u == (gen + 1u) * nloc) {
      __builtin_amdgcn_fence(__ATOMIC_RELEASE, "agent");
      asm volatile("s_waitcnt vmcnt(0)" ::: "memory");
      const unsigned og = xb_add(&bar[XB_TOP], 1u);
      const unsigned tg = og / nx;
      if (og + 1u == (tg + 1u) * nx) xb_add(&bar[XB_TOPGEN], 1u);
      else XB_SPIN(xb_ld(&bar[XB_TOPGEN]) == tg, bar);
      __builtin_amdgcn_fence(__ATOMIC_ACQUIRE, "agent");
      xb_add(&bar[XB_XGEN(b.x)], 1u);
      asm volatile("s_waitcnt vmcnt(0)" ::: "memory");
    } else {
      XB_SPIN(xb_ld(&bar[XB_XGEN(b.x)]) == gen, bar);
      __builtin_amdgcn_fence(__ATOMIC_ACQUIRE, "agent");
      asm volatile("s_waitcnt vmcnt(0)" ::: "memory");
    }
  }
  __syncthreads();
}

#define PHASE(k, call)                                   \
  {                                                        \
    if ((k) == 1) grid.sync();                             \
    else if ((k) > 1) xcd_barrier((unsigned*)(P.ws + OFF_BAR), (volatile LAS unsigned*)(smem + 131072)); \
    call;                                                  \
  }
__global__ void __launch_bounds__(NT) fwd_kernel(Params P) {
  extern __shared__ __attribute__((aligned(16))) unsigned char smem[];
  cg::grid_group grid = cg::this_grid();
  volatile LAS unsigned* xst = (volatile LAS unsigned*)(smem + 131072);
  if (threadIdx.x < 2) xst[threadIdx.x] = 0u;
  __syncthreads();
  (void)xcd_barrier_post((unsigned*)(P.ws + OFF_BAR), xst);
  PHASE(0, phase0(smem, P))
  PHASE(1, phase_rownorm(P, 3); xcd_barrier((unsigned*)(P.ws + OFF_BAR), (volatile LAS unsigned*)(smem + 131072));
           if (blockIdx.x < 16) phase_gemm1(smem, P, 1); else phase_rownorm(P, 0))
  PHASE(2, phase_gemm1(smem, P, 0))
  PHASE(3, phase_s5g1(smem, P))
  PHASE(4, phase_s5scan(P))
  PHASE(5, phase_s5g2(smem, P))
  PHASE(6, phase_glu(smem, P); phase_hyena(smem, P))
  PHASE(8, phase_mixnorm(smem, P))
  PHASE(9, phase_wout(smem, P))
  PHASE(10, phase_rownorm(P, 1))
  PHASE(11, phase_mlp1(smem, P))
  PHASE(12, phase_mlp2(smem, P))
  PHASE(13, phase_rownorm(P, 2))
}

extern "C" void kernel_launch(void* const* d_in, const int* in_sizes, int n_in, void* d_out, int out_size, void* d_ws,
                              size_t ws_size, hipStream_t stream) {
  static int grid_blocks = 0;
  if (!grid_blocks) {
    int dev = 0, cus = 0, per_cu = 0;
    (void)hipGetDevice(&dev);
    (void)hipDeviceGetAttribute(&cus, hipDeviceAttributeMultiprocessorCount, dev);
    (void)hipFuncSetAttribute((const void*)fwd_kernel, hipFuncAttributeMaxDynamicSharedMemorySize, LDS_BYTES);
    (void)hipOccupancyMaxActiveBlocksPerMultiprocessor(&per_cu, (const void*)fwd_kernel, NT, LDS_BYTES);
    if (per_cu < 1) per_cu = 1;
    if (cus < 1) cus = 256;
    grid_blocks = cus * per_cu;
    (void)hipGetLastError();
  }
  if (n_in != 35 || ws_size < WS_NEED) {
    fprintf(stderr, "kernel_launch: unexpected n_in %d or ws_size %zu\n", n_in, ws_size);
    return;
  }
  Params p;
  memset(&p, 0, sizeof(p));
  for (int i = 0; i < 35; ++i) p.in[i] = (const float*)d_in[i];
  p.out = (float*)d_out;
  p.ws = (unsigned char*)d_ws;
  (void)hipMemsetAsync((unsigned char*)d_ws + OFF_BAR, 0, XCD_BAR_WORDS * sizeof(unsigned), stream);
  p.ph_lo = 0; p.ph_hi = N_PHASES;
  void* args[] = {&p};
  hipError_t e = hipLaunchCooperativeKernel((const void*)fwd_kernel, dim3(grid_blocks), dim3(NT), args, LDS_BYTES, stream);
  if (e != hipSuccess) fprintf(stderr, "cooperative launch failed: %s (grid %d)\n", hipGetErrorString(e), grid_blocks);
}
```

```cpp
#include <hip/hip_runtime.h>
#include <hip/hip_cooperative_groups.h>
#include <stdint.h>
#include <stdio.h>
#include <string.h>
namespace cg = cooperative_groups;

#define NT 512
#define LDS_BYTES (131072 + 16)
#define N_PHASES 14
#ifndef MULTI_LAUNCH
#define MULTI_LAUNCH 0
#endif

typedef unsigned short bf16_t;
using bf16x8 = __attribute__((ext_vector_type(8))) short;
using f32x4 = __attribute__((ext_vector_type(4))) float;

#define MiB ((size_t)1 << 20)
#define OFF_WTIN (0 * MiB)
#define OFF_WTGLU (4 * MiB)
#define OFF_WTOUT (5 * MiB)
#define OFF_WT1 (7 * MiB)
#define OFF_WT2 (15 * MiB)
#define OFF_S5WIN (23 * MiB)
#define OFF_S5WCAT (27 * MiB)
#define OFF_MOD (35 * MiB)
#define OFF_POS (36 * MiB)
#define OFF_A1 (37 * MiB)
#define OFF_YS5 (105 * MiB)
#define OFF_A2 (137 * MiB)
#define OFF_SLOC (205 * MiB)
#define OFF_Z (273 * MiB)
#define OFF_FILT (369 * MiB)
#define OFF_YS5G (401 * MiB)
#define OFF_HID (137 * MiB)
#define OFF_Z1 (433 * MiB)
#define OFF_BAR (465 * MiB)
#define WS_NEED (466 * MiB)

struct Params {
  const float* in[35];
  float* out;
  unsigned char* ws;
  int ph_lo, ph_hi;
};

__device__ __forceinline__ unsigned short f2bf(float f) {
  unsigned u = __float_as_uint(f);
  u += 0x7fffu + ((u >> 16) & 1u);
  return (unsigned short)(u >> 16);
}
__device__ __forceinline__ float bf2f(unsigned short h) { return __uint_as_float(((unsigned)h) << 16); }
__device__ __forceinline__ unsigned pack2(float a, float b) { return (unsigned)f2bf(a) | ((unsigned)f2bf(b) << 16); }
__device__ __forceinline__ float sinrev(float r) { return __builtin_amdgcn_sinf(r); }
__device__ __forceinline__ float cosrev(float r) { return __builtin_amdgcn_cosf(r); }
#define INV2PI 0.15915494309189535f
__device__ __forceinline__ float hsin(float x) { return __builtin_amdgcn_sinf(x * INV2PI); }
__device__ __forceinline__ float hcos(float x) { return __builtin_amdgcn_cosf(x * INV2PI); }
__device__ __forceinline__ float wave_sum(float v) {
#pragma unroll
  for (int o = 32; o >= 1; o >>= 1) v += __shfl_xor(v, o, 64);
  return v;
}
__device__ __forceinline__ float gelu_tanh(float x) {
  float z = 0.7978845608028654f * (x + 0.044715f * x * x * x);
  float e = __expf(2.0f * z);
  float t = 1.0f - 2.0f / (e + 1.0f);
  return 0.5f * x * (1.0f + t);
}

struct ALin {
  const bf16_t* p; int ld;
  __device__ __forceinline__ const bf16_t* operator()(int m, int k) const { return p + (unsigned)(m * ld + k); }
};
struct ABlk {
  const bf16_t* p; int M;
  __device__ __forceinline__ const bf16_t* operator()(int m, int k) const {
    return p + (unsigned)(((k >> 5) * M + m) * 32 + (k & 31));
  }
};
struct AGlu {
  const bf16_t* p;
  __device__ __forceinline__ const bf16_t* operator()(int m, int k) const {
    return p + (unsigned)(((k >> 4) * 32768 + m) * 16 + (k & 15));
  }
};

#define G_DMA(STEP, STAGE_OFF)                                                                     \
  {                                                                                                \
    const int s_ = min((STEP), ns - 1);                                                            \
    _Pragma("unroll") for (int i = 0; i < 4; ++i) {                                                \
      const int p_ = wave * 4 + i;                                                                 \
      const bf16_t* g_;                                                                            \
      if (wave < 4) g_ = af(min(m0 + p_ * 16 + (lane >> 2), mmax - 1), s_ * 32 + dchunk * 8);      \
      else g_ = W + (unsigned)((s_ * ldw + n0 + (p_ - 16) * 16 + (lane >> 2)) * 32 + dchunk * 8); \
      __builtin_amdgcn_global_load_lds((const unsigned*)g_, (unsigned*)(smem + (STAGE_OFF) + p_ * 1024 + lane * 16), 16, 0, 0); \
    }                                                                                              \
  }
#define G_READ_LO(OFF, FAL)                                                                        \
  {                                                                                                \
    const unsigned char* pa_ = smem + (OFF) + rdA_off;                                             \
    _Pragma("unroll") for (int mt = 0; mt < 4; ++mt) FAL[mt] = *(const bf16x8*)(pa_ + mt * 16 * 64); \
  }
#define G_READ_B(OFF, FB)                                                                          \
  {                                                                                                \
    const unsigned char* pb_ = smem + (OFF) + rdB_off;                                             \
    _Pragma("unroll") for (int nt = 0; nt < 4; ++nt) FB[nt] = *(const bf16x8*)(pb_ + nt * 16 * 64); \
  }
#define G_READ_HI(OFF, FAH)                                                                        \
  {                                                                                                \
    const unsigned char* pa_ = smem + (OFF) + rdA_off + 64 * 64;                                   \
    _Pragma("unroll") for (int mt = 0; mt < 4; ++mt) FAH[mt] = *(const bf16x8*)(pa_ + mt * 16 * 64); \
  }
#define G_MMA_H(H, FA, FB)                                                                         \
  {                                                                                                \
    _Pragma("unroll") for (int mt = 0; mt < 4; ++mt)                                               \
      _Pragma("unroll") for (int nt = 0; nt < 4; ++nt)                                             \
        acc[(H) * 4 + mt][nt] = __builtin_amdgcn_mfma_f32_16x16x32_bf16(FB[nt], FA[mt], acc[(H) * 4 + mt][nt], 0, 0, 0); \
  }
#define SB __builtin_amdgcn_sched_barrier(0)
#define WAIT_BAR(N) asm volatile("s_waitcnt vmcnt(" #N ")\n\ts_barrier" ::: "memory")
#define STAGE_B 32768

template <class AF>
__device__ __forceinline__ void gemm_tile(unsigned char* smem, const AF& af, const bf16_t* __restrict__ W, int ldw,
                                          int nk, int m0, int n0, int mmax, f32x4 (&acc)[8][4]) {
  const int tid = threadIdx.x, lane = tid & 63, wave = tid >> 6;
  const int wm = wave >> 2, wn = wave & 3;
  const int r = lane & 15, q = lane >> 4;
  const int ns = nk * 2;
#pragma unroll
  for (int i = 0; i < 8; ++i)
#pragma unroll
    for (int j = 0; j < 4; ++j) acc[i][j] = (f32x4){0.f, 0.f, 0.f, 0.f};
  const int dchunk = (lane & 3) ^ ((4 - ((lane >> 4) & 3)) & 3);
  const int rpos = (q ^ ((4 - ((r >> 2) & 3)) & 3)) << 4;
  const int rdA_off = (wm * 128 + r) * 64 + rpos;
  const int rdB_off = 16384 + (wn * 64 + r) * 64 + rpos;
  bf16x8 fb[4], falA[4], falB[4], fah[4];
  G_DMA(0, 0);
  G_DMA(1, STAGE_B);
  G_DMA(2, 2 * STAGE_B);
  WAIT_BAR(4);
  G_READ_B(0, fb);
  G_READ_LO(0, falA);
  int o0 = 0, o1 = STAGE_B, o2 = 2 * STAGE_B, o3 = 3 * STAGE_B;
#define MID_BAR asm volatile("s_waitcnt lgkmcnt(0)\n\ts_barrier" ::: "memory")
  if (wm == 1) __builtin_amdgcn_s_barrier();
#pragma unroll 1
  for (int t = 0; t < ns; t += 2) {
    G_DMA(t + 3, o3);
    SB;
    G_READ_HI(o0, fah);
    G_MMA_H(0, falA, fb);
    SB;
    MID_BAR;
    G_READ_LO(o1, falB);
    G_MMA_H(1, fah, fb);
    SB;
    G_READ_B(o1, fb);
    WAIT_BAR(4);
    { int tmp = o0; o0 = o1; o1 = o2; o2 = o3; o3 = tmp; }
    G_DMA(t + 4, o3);
    SB;
    G_READ_HI(o0, fah);
    G_MMA_H(0, falB, fb);
    SB;
    MID_BAR;
    G_READ_LO(o1, falA);
    G_MMA_H(1, fah, fb);
    SB;
    G_READ_B(o1, fb);
    WAIT_BAR(4);
    { int tmp = o0; o0 = o1; o1 = o2; o2 = o3; o3 = tmp; }
  }
  if (wm == 0) __builtin_amdgcn_s_barrier();
  asm volatile("s_waitcnt vmcnt(0) lgkmcnt(0)\n\ts_barrier" ::: "memory");
}

__device__ __forceinline__ void wconv_item(const float* __restrict__ src, int N, bf16_t* __restrict__ dst, int kb, int n,
                                           int glu, const float* ks1, const float* ks2) {
  float v[32];
  const float* sp = src + (size_t)(kb * 32) * N + n;
#pragma unroll
  for (int i = 0; i < 32; ++i) v[i] = sp[(size_t)i * N];
  if (ks1) {
#pragma unroll
    for (int i = 0; i < 32; ++i) { int k = kb * 32 + i; v[i] *= (k < 512) ? ks1[k] : ks2[k - 512]; }
  }
  int nd = n;
  if (glu) { int sgl = n >> 9, f = n & 511; nd = 64 * (f >> 5) + 32 * sgl + (f & 31); }
  uint4* dp = (uint4*)(dst + ((size_t)kb * N + nd) * 32);
#pragma unroll
  for (int c = 0; c < 4; ++c) {
    uint4 o;
    o.x = pack2(v[c * 8 + 0], v[c * 8 + 1]); o.y = pack2(v[c * 8 + 2], v[c * 8 + 3]);
    o.z = pack2(v[c * 8 + 4], v[c * 8 + 5]); o.w = pack2(v[c * 8 + 6], v[c * 8 + 7]);
    dp[c] = o;
  }
}

__device__ void job_mod(float* lds, const Params& P, int j) {
  const int tid = threadIdx.x;
  float* sc = lds; float* red = lds + 9216;
  const float* c = P.in[1]; const float* cctx = P.in[3];
  const float* aw = P.in[4]; const float* ab = P.in[5];
  float* mod = (float*)(P.ws + OFF_MOD);
  for (int e = tid; e < 9216; e += NT) {
    int rr = e >> 10, k = e & 1023;
    float v = rr < 8 ? c[rr * 1024 + k] : cctx[k];
    sc[e] = v / (1.0f + __expf(-v));
  }
  __syncthreads();
  const int n0 = j * 64, col = tid & 63, kg = tid >> 6;
  float acc[9];
#pragma unroll
  for (int i = 0; i < 9; ++i) acc[i] = 0.f;
#pragma unroll 16
  for (int k = kg * 128; k < kg * 128 + 128; ++k) {
    float w = aw[(size_t)k * 6144 + n0 + col];
#pragma unroll
    for (int i = 0; i < 9; ++i) acc[i] += sc[i * 1024 + k] * w;
  }
#pragma unroll
  for (int i = 0; i < 9; ++i) red[(kg * 9 + i) * 64 + col] = acc[i];
  __syncthreads();
  for (int e = tid; e < 576; e += NT) {
    int rr = e >> 6, cc = e & 63;
    float s = ab[n0 + cc];
#pragma unroll
    for (int g = 0; g < 8; ++g) s += red[(g * 9 + rr) * 64 + cc];
    mod[rr * 6144 + n0 + cc] = s;
  }
  __syncthreads();
}

__device__ void job_pos(const Params& P) {
  float* E = (float*)(P.ws + OFF_POS);
  for (int e = threadIdx.x; e < 64 * 512; e += NT) {
    int p = e >> 9, d = e & 511, i = d & 255;
    float omega = exp2f(-(float)i * (13.287712379549449f / 256.0f));
    float ang = (float)p * omega;
    E[e] = d < 256 ? hsin(ang) : hcos(ang);
  }
}

__device__ void job_s5mats(float* lds, const Params& P, int g, int sj) {
  const int tid = threadIdx.x;
  float2* pw = (float2*)lds;
  float2* bb = pw + 2 * 17 * 64;
  float2* cc = bb + 2 * 64 * 16;
  float* KK = (float*)(cc + 2 * 16 * 64);
  const float* a_re = P.in[8]; const float* a_im = P.in[9]; const float* lstep = P.in[10];
  const float* b_re = P.in[11]; const float* b_im = P.in[12];
  const float* c_re = P.in[13]; const float* c_im = P.in[14];
  const float* dsk = P.in[15];
  bf16_t* Win = (bf16_t*)(P.ws + OFF_S5WIN) + (size_t)g * 65536;
  bf16_t* Wcat = (bf16_t*)(P.ws + OFF_S5WCAT) + (size_t)g * 131072;
  for (int e = tid; e < 2 * 17 * 64; e += NT) {
    int d = e / 1088, rem = e % 1088, tau = rem >> 6, p = rem & 63;
    float are = a_re[(d * 32 + g) * 64 + p], aim = a_im[(d * 32 + g) * 64 + p];
    float step = __expf(lstep[d * 32 + g]);
    float mag = __expf(are * step * (float)tau);
    float ang = aim * step * (float)tau;
    pw[e] = make_float2(mag * hcos(ang), mag * hsin(ang));
  }
  for (int e = tid; e < 2 * 64 * 16; e += NT) {
    int d = e >> 10, p = (e >> 4) & 63, ch = e & 15;
    float are = a_re[(d * 32 + g) * 64 + p], aim = a_im[(d * 32 + g) * 64 + p];
    float step = __expf(lstep[d * 32 + g]);
    float mag = __expf(are * step);
    float ang = aim * step;
    float nr = mag * hcos(ang) - 1.0f, ni = mag * hsin(ang);
    float den = 1.0f / (are * are + aim * aim);
    float qr = (nr * are + ni * aim) * den, qi = (ni * are - nr * aim) * den;
    size_t bi = ((size_t)((d * 32 + g) * 64 + p)) * 16 + ch;
    float br = b_re[bi], bim = b_im[bi];
    bb[e] = make_float2(qr * br - qi * bim, qr * bim + qi * br);
  }
  for (int e = tid; e < 2 * 16 * 64; e += NT) {
    int d = e >> 10, ch = (e >> 6) & 15, p = e & 63;
    size_t ci = ((size_t)((d * 32 + g) * 16 + ch)) * 64 + p;
    cc[e] = make_float2(c_re[ci], c_im[ci]);
  }
  __syncthreads();
  for (int e0 = tid; e0 < 2048; e0 += NT) {
    int d = e0 >> 10, tau = sj * 4 + ((e0 >> 8) & 3), ch = (e0 >> 4) & 15, ch2 = e0 & 15;
    int e = (d << 12) | (tau << 8) | (ch << 4) | ch2;
    float s = 0.f;
    for (int p = 0; p < 64; ++p) {
      float2 c = cc[(d * 16 + ch) * 64 + p], w = pw[(d * 17 + tau) * 64 + p], b = bb[(d * 64 + p) * 16 + ch2];
      float cr = c.x * w.x - c.y * w.y, ci = c.x * w.y + c.y * w.x;
      s += cr * b.x - ci * b.y;
    }
    KK[e] = s;
  }
  for (int e = tid * 4 + sj; e < 8192; e += NT * 4) {
    int n = e >> 5, k8 = (e & 31) * 8;
    int d = n >> 7, p = (n & 127) >> 1, ri = n & 1;
    int i = k8 >> 4, ch0 = k8 & 15;
    int tau = d == 0 ? 15 - i : i;
    float2 w = pw[(d * 17 + tau) * 64 + p];
    float v[8];
#pragma unroll
    for (int t = 0; t < 8; ++t) {
      float2 b = bb[(d * 64 + p) * 16 + ch0 + t];
      v[t] = ri ? (w.x * b.y + w.y * b.x) : (w.x * b.x - w.y * b.y);
    }
    uint4 o; o.x = pack2(v[0], v[1]); o.y = pack2(v[2], v[3]); o.z = pack2(v[4], v[5]); o.w = pack2(v[6], v[7]);
    *(uint4*)(Win + ((size_t)(k8 >> 5) * 256 + n) * 32 + (k8 & 31)) = o;
  }
  for (int e = tid * 4 + sj; e < 8192; e += NT * 4) {
    int n = e >> 5, k8 = (e & 31) * 8;
    int j = n >> 4, ch = n & 15;
    float v[8];
#pragma unroll
    for (int t = 0; t < 8; ++t) {
      int kk = k8 + t;
      int d = kk >> 7, p = (kk & 127) >> 1, ri = kk & 1;
      int tau = d == 0 ? j + 1 : 16 - j;
      float2 c = cc[(d * 16 + ch) * 64 + p], w = pw[(d * 17 + tau) * 64 + p];
      v[t] = ri ? -(c.x * w.y + c.y * w.x) : (c.x * w.x - c.y * w.y);
    }
    uint4 o; o.x = pack2(v[0], v[1]); o.y = pack2(v[2], v[3]); o.z = pack2(v[4], v[5]); o.w = pack2(v[6], v[7]);
    *(uint4*)(Wcat + ((size_t)((256 + k8) >> 5) * 256 + n) * 32 + (k8 & 31)) = o;
  }
  __syncthreads();
  for (int e = tid; e < 8192; e += NT) {
    int n = e >> 5, k8 = (e & 31) * 8;
    int j = n >> 4, ch = n & 15;
    int i = k8 >> 4, ch0 = k8 & 15;
    if (((i > j ? i - j : j - i) >> 2) != sj) continue;
    float v[8];
#pragma unroll
    for (int t = 0; t < 8; ++t) {
      int ch2 = ch0 + t;
      float s = 0.f;
      if (i <= j) s += KK[((0 * 16 + (j - i)) * 16 + ch) * 16 + ch2];
      if (i >= j) s += KK[((1 * 16 + (i - j)) * 16 + ch) * 16 + ch2];
      if (i == j && ch == ch2) s += dsk[g * 16 + ch];
      v[t] = s;
    }
    uint4 o; o.x = pack2(v[0], v[1]); o.y = pack2(v[2], v[3]); o.z = pack2(v[4], v[5]); o.w = pack2(v[6], v[7]);
    *(uint4*)(Wcat + ((size_t)(k8 >> 5) * 256 + n) * 32 + (k8 & 31)) = o;
  }
  __syncthreads();
}

__device__ void job_filter(float* lds, const Params& P, int it) {
  const int tid = threadIdx.x;
  float* emb = lds;
  float* h1 = lds + 528;
  float* h2s = lds + 528 + 1024;
  const float* w1 = P.in[20]; const float* b1 = P.in[21]; const float* w2 = P.in[22]; const float* b2 = P.in[23];
  const float* fr = P.in[24]; const float* w3 = P.in[25]; const float* decay = P.in[26];
  float* filt = (float*)(P.ws + OFF_FILT);
  const int t0 = it * 16;
  for (int e = tid; e < 16 * 33; e += NT) {
    int tt = e / 33, qq = e % 33;
    int t = t0 + tt;
    float val;
    if (qq == 0) val = (float)t / 4095.0f;
    else {
      int k = (qq - 1) & 15;
      float band = 1e-4f + (float)k * ((15.0f - 1e-4f) / 15.0f);
      float rev = (float)t * band * (1.0f / 4096.0f);
      val = qq <= 16 ? cosrev(rev) : -sinrev(rev);
    }
    emb[e] = val;
  }
  __syncthreads();
  for (int e = tid; e < 1024; e += NT) {
    int tt = e >> 6, m = e & 63;
    float s = b1[m];
#pragma unroll 11
    for (int qq = 0; qq < 33; ++qq) s += emb[tt * 33 + qq] * w1[qq * 64 + m];
    h1[e] = hsin(fr[m] * s);
  }
  __syncthreads();
  for (int e = tid; e < 1024; e += NT) {
    int tt = e >> 6, m = e & 63;
    float s = b2[m];
#pragma unroll 16
    for (int qq = 0; qq < 64; ++qq) s += h1[tt * 64 + qq] * w2[qq * 64 + m];
    h2s[m * 16 + tt] = hsin(fr[m] * s);
  }
  __syncthreads();
  {
    float acc[4][16];
#pragma unroll
    for (int cq = 0; cq < 4; ++cq)
#pragma unroll
      for (int i = 0; i < 16; ++i) acc[cq][i] = 0.f;
#pragma unroll 4
    for (int m = 0; m < 64; ++m) {
      float w[4];
#pragma unroll
      for (int cq = 0; cq < 4; ++cq) w[cq] = w3[m * 2048 + tid + 512 * cq];
      const float4* hp = (const float4*)(h2s + m * 16);
#pragma unroll
      for (int i = 0; i < 4; ++i) {
        float4 h = hp[i];
#pragma unroll
        for (int cq = 0; cq < 4; ++cq) {
          acc[cq][i * 4 + 0] += h.x * w[cq]; acc[cq][i * 4 + 1] += h.y * w[cq];
          acc[cq][i * 4 + 2] += h.z * w[cq]; acc[cq][i * 4 + 3] += h.w * w[cq];
        }
      }
    }
#pragma unroll
    for (int cq = 0; cq < 4; ++cq) {
      int col = tid + 512 * cq;
      int order = col >> 10, dir = (col >> 9) & 1, c = col & 511;
      float dec = fabsf(decay[order * 512 + c]);
      float* dst = filt + ((size_t)((order * 2 + dir) * 512 + c)) * 4096 + t0;
#pragma unroll
      for (int i = 0; i < 4; ++i) {
        float4 o;
        o.x = acc[cq][i * 4 + 0] * __expf(-((float)(t0 + i * 4 + 0) / 4095.0f) * dec);
        o.y = acc[cq][i * 4 + 1] * __expf(-((float)(t0 + i * 4 + 1) / 4095.0f) * dec);
        o.z = acc[cq][i * 4 + 2] * __expf(-((float)(t0 + i * 4 + 2) / 4095.0f) * dec);
        o.w = acc[cq][i * 4 + 3] * __expf(-((float)(t0 + i * 4 + 3) / 4095.0f) * dec);
        *(float4*)(dst + i * 4) = o;
      }
    }
  }
  __syncthreads();
}

__device__ void phase0(unsigned char* smem, const Params& P) {
  float* lds = (float*)smem;
  const int G = gridDim.x;
  {
    const int nthreads = G * NT;
#pragma unroll 1
    for (int it = blockIdx.x * NT + threadIdx.x; it < 376832; it += nthreads) {
      int u = it;
      if (u < 65536) wconv_item(P.in[7], 2048, (bf16_t*)(P.ws + OFF_WTIN), u >> 11, u & 2047, 0, nullptr, nullptr);
      else if ((u -= 65536) < 16384) wconv_item(P.in[16], 1024, (bf16_t*)(P.ws + OFF_WTGLU), u >> 10, u & 1023, 1, nullptr, nullptr);
      else if ((u -= 16384) < 32768) wconv_item(P.in[30], 1024, (bf16_t*)(P.ws + OFF_WTOUT), u >> 10, u & 1023, 0, P.in[28], P.in[29]);
      else if ((u -= 32768) < 131072) wconv_item(P.in[32], 4096, (bf16_t*)(P.ws + OFF_WT1), u >> 12, u & 4095, 0, nullptr, nullptr);
      else { u -= 131072; wconv_item(P.in[33], 1024, (bf16_t*)(P.ws + OFF_WT2), u >> 10, u & 1023, 0, nullptr, nullptr); }
    }
  }
#pragma unroll 1
  for (int w = blockIdx.x; w < 256; w += G) job_filter(lds, P, w);
#pragma unroll 1
  for (int w = (blockIdx.x + 128) % G; w < 128; w += G) job_s5mats(lds, P, w >> 2, w & 3);
#pragma unroll 1
  for (int w = blockIdx.x; w < 96; w += G) job_mod(lds, P, w);
  if (blockIdx.x == 100) job_pos(P);
}

#define NRF 4
__device__ __forceinline__ void phase_rownorm(const Params& P, int mode) {
  const int lane = threadIdx.x & 63, wave = threadIdx.x >> 6;
  const float* mod = (const float*)(P.ws + OFF_MOD);
  const float* E = (const float*)(P.ws + OFF_POS);
  bf16_t* A1 = (bf16_t*)(P.ws + OFF_A1);
  const bool first = (mode == 0 || mode == 3);
  const int nrows = mode == 3 ? 34816 : 32768;
  const float* gain = first ? P.in[6] : (mode == 1 ? P.in[31] : P.in[34]);
  const int sh_off = first ? 0 : 3072, sc_off = first ? 1024 : 4096;
  const int nblk = mode == 0 ? (int)gridDim.x - 16 : (int)gridDim.x;
  const int bid = mode == 0 ? (int)blockIdx.x - 16 : (int)blockIdx.x;
  const int stride = nblk * 8;
  const int rbeg = mode == 3 ? 32768 : 0;
#pragma unroll 1
  for (int row0 = rbeg + bid * 8 + wave; row0 < nrows; row0 += NRF * stride) {
    float4 v[NRF][4];
    float ss[NRF];
    int bsel[NRF];
#pragma unroll
    for (int j = 0; j < NRF; ++j) {
      int row = min(row0 + j * stride, nrows - 1);
      const float* src;
      if (first) {
        if (row < 32768) { src = P.in[0] + (size_t)row * 1024; bsel[j] = row >> 12; }
        else { src = P.in[2] + (size_t)(row - 32768) * 1024; bsel[j] = 8; }
      } else { src = P.out + (size_t)row * 1024; bsel[j] = row >> 12; }
#pragma unroll
      for (int i = 0; i < 4; ++i) v[j][i] = *(const float4*)(src + lane * 4 + 256 * i);
    }
#pragma unroll
    for (int j = 0; j < NRF; ++j) {
      int row = min(row0 + j * stride, nrows - 1);
      float s = 0.f;
#pragma unroll
      for (int i = 0; i < 4; ++i) {
        int d = lane * 4 + 256 * i;
        if (first && row < 32768) {
          int l = row & 4095;
          float4 e = (i < 2) ? *(const float4*)(E + (l >> 6) * 512 + d) : *(const float4*)(E + (l & 63) * 512 + d - 512);
          v[j][i].x += e.x; v[j][i].y += e.y; v[j][i].z += e.z; v[j][i].w += e.w;
        }
        s += v[j][i].x * v[j][i].x + v[j][i].y * v[j][i].y + v[j][i].z * v[j][i].z + v[j][i].w * v[j][i].w;
      }
      ss[j] = s;
    }
#pragma unroll
    for (int j = 0; j < NRF; ++j) ss[j] = wave_sum(ss[j]);
#pragma unroll
    for (int j = 0; j < NRF; ++j) {
      int row = row0 + j * stride;
      if (row >= nrows) continue;
      const int b = bsel[j];
      float rinv = rsqrtf(ss[j] * (1.0f / 1024.0f) + 1e-6f);
#pragma unroll
      for (int i = 0; i < 4; ++i) {
        int d = lane * 4 + 256 * i;
        float4 g = *(const float4*)(gain + d);
        float4 o;
        o.x = v[j][i].x * rinv * g.x; o.y = v[j][i].y * rinv * g.y; o.z = v[j][i].z * rinv * g.z; o.w = v[j][i].w * rinv * g.w;
        if (mode == 2) {
          *(float4*)(P.out + (size_t)row * 1024 + d) = o;
        } else {
          float4 sc = *(const float4*)(mod + b * 6144 + sc_off + d);
          float4 sh = *(const float4*)(mod + b * 6144 + sh_off + d);
          o.x = o.x * (1.0f + sc.x) + sh.x; o.y = o.y * (1.0f + sc.y) + sh.y;
          o.z = o.z * (1.0f + sc.z) + sh.z; o.w = o.w * (1.0f + sc.w) + sh.w;
          uint2 pk; pk.x = pack2(o.x, o.y); pk.y = pack2(o.z, o.w);
          *(uint2*)(A1 + ((size_t)(d >> 5) * 34816 + row) * 32 + (d & 31)) = pk;
        }
      }
    }
  }
}

__device__ __forceinline__ void tile_map(int t, int lg, int& tm, int& tn) {
  if (gridDim.x != 256) { tm = t >> lg; tn = t & ((1 << lg) - 1); return; }
  const int round = t >> 8, bid = t & 255, x = bid & 7, j = bid >> 3;
  if (lg == 2) { tm = round * 64 + x * 8 + (j >> 2); tn = j & 3; }
  else if (lg == 3) { tm = round * 32 + x * 4 + (j >> 3); tn = j & 7; }
  else { tm = round * 16 + (x >> 1) * 4 + (j >> 3); tn = (x & 1) * 8 + (j & 7); }
}

__device__ __forceinline__ void phase_gemm1(unsigned char* smem, const Params& P, int ctx_only) {
  const int lane = threadIdx.x & 63, wave = threadIdx.x >> 6, wm = wave >> 2, wn = wave & 3, r = lane & 15, q = lane >> 4;
  ABlk af{(const bf16_t*)(P.ws + OFF_A1), 34816};
  const bf16_t* W = (const bf16_t*)(P.ws + OFF_WTIN);
  bf16_t* A2 = (bf16_t*)(P.ws + OFF_A2);
  bf16_t* Z = (bf16_t*)(P.ws + OFF_Z);
  unsigned char* stg = smem + wave * 9216;
  for (int t = ctx_only ? 1024 + (int)blockIdx.x : (int)blockIdx.x; t < (ctx_only ? 1040 : 1024); t += gridDim.x) {
    int tm, tn;
    if (t < 1024) tile_map(t, 3, tm, tn); else { tm = 128 + ((t - 1024) >> 1); tn = t & 1; }
    f32x4 acc[8][4];
    gemm_tile(smem, af, W, 2048, 16, tm * 256, tn * 256, 34816, acc);
    if (tn < 2) {
#pragma unroll
      for (int half = 0; half < 2; ++half) {
#pragma unroll
        for (int mt = 0; mt < 4; ++mt) {
#pragma unroll
          for (int nt = 0; nt < 4; ++nt) {
            f32x4 a = acc[half * 4 + mt][nt];
            uint2 pk; pk.x = pack2(a[0], a[1]); pk.y = pack2(a[2], a[3]);
            *(uint2*)(stg + ((mt * 4 + nt) * 16 + r) * 32 + q * 8) = pk;
          }
        }
        __builtin_amdgcn_sched_barrier(0);
        const int mbase = tm * 256 + wm * 128 + half * 64;
        int rowbase;
        if (mbase < 32768) rowbase = (mbase >> 12) * 256 + ((mbase & 4095) >> 4);
        else { int mc = mbase - 32768; rowbase = 2048 + (mc >> 8) * 16 + ((mc & 255) >> 4); }
        const int g0 = (tn * 256 + wn * 64) >> 4;
#pragma unroll
        for (int i = 0; i < 8; ++i) {
          const int blk = i * 2 + (lane >> 5);
          const int mt = blk >> 2, nt = blk & 3;
          uint4 v = *(const uint4*)(stg + blk * 512 + (lane & 31) * 16);
          *(uint4*)(A2 + ((size_t)((g0 + nt) * 2176 + rowbase + mt)) * 512 + (lane & 31) * 8) = v;
        }
        __builtin_amdgcn_sched_barrier(0);
      }
    } else {
      const int cz0 = tn * 256 + wn * 64 - 512;
#pragma unroll
      for (int half = 0; half < 2; ++half) {
#pragma unroll
        for (int mt = 0; mt < 4; ++mt) {
#pragma unroll
          for (int nt = 0; nt < 4; ++nt) {
            f32x4 a = acc[half * 4 + mt][nt];
#pragma unroll
            for (int jj = 0; jj < 4; ++jj)
              *(bf16_t*)(stg + (nt * 16 + 4 * q + jj) * 144 + (mt * 16 + r) * 2) = f2bf(a[jj]);
          }
        }
        __builtin_amdgcn_sched_barrier(0);
        const int mbase = tm * 256 + wm * 128 + half * 64;
        const int b = mbase >> 12, l0 = mbase & 4095;
#pragma unroll
        for (int i = 0; i < 8; ++i) {
          int row = i * 8 + (lane >> 3), chunk = lane & 7;
          uint4 v = *(const uint4*)(stg + row * 144 + chunk * 16);
          *(uint4*)(Z + ((size_t)((cz0 + row) * 8 + b)) * 4096 + l0 + chunk * 8) = v;
        }
        __builtin_amdgcn_sched_barrier(0);
      }
    }
    __syncthreads();
  }
}

__device__ void phase_s5g1(unsigned char* smem, const Params& P) {
  const int lane = threadIdx.x & 63, wave = threadIdx.x >> 6, wm = wave >> 2, wn = wave & 3, r = lane & 15, q = lane >> 4;
  float* Sloc = (float*)(P.ws + OFF_SLOC);
  for (int t = blockIdx.x; t < 288; t += gridDim.x) {
    int g = t / 9, tm = t % 9, tn = 0;
    ALin af{(const bf16_t*)(P.ws + OFF_A2) + (size_t)g * 2176 * 512, 512};
    const bf16_t* W = (const bf16_t*)(P.ws + OFF_S5WIN) + (size_t)g * 65536;
    f32x4 acc[8][4];
    gemm_tile(smem, af, W, 256, 4, tm * 256, tn * 256, 2176, acc);
#pragma unroll
    for (int mt = 0; mt < 8; ++mt) {
      int m = tm * 256 + wm * 128 + mt * 16 + r;
      if (m < 2176) {
#pragma unroll
        for (int nt = 0; nt < 4; ++nt) {
          int n = tn * 256 + wn * 64 + nt * 16 + 4 * q;
          f32x4 a = acc[mt][nt];
          *(float4*)(Sloc + ((size_t)(g * 2176 + m)) * 256 + n) = make_float4(a[0], a[1], a[2], a[3]);
        }
      }
    }
  }
}

__device__ void phase_s5scan(const Params& P) {
  const float* a_re = P.in[8]; const float* a_im = P.in[9]; const float* lstep = P.in[10];
  if (threadIdx.x >= 128) return;
  for (int idx = blockIdx.x * 128 + threadIdx.x; idx < 32768; idx += gridDim.x * 128) {
    int p = idx & 63, b = (idx >> 6) & 7, d = (idx >> 9) & 1, g = idx >> 10;
    float are = a_re[(d * 32 + g) * 64 + p], aim = a_im[(d * 32 + g) * 64 + p];
    float step = __expf(lstep[d * 32 + g]);
    float mag = __expf(are * step * 16.0f), ang = aim * step * 16.0f;
    float lr_ = mag * hcos(ang), li_ = mag * hsin(ang);
    const float* sl = (const float*)(P.ws + OFF_SLOC) + (size_t)g * 2176 * 256 + d * 128 + 2 * p;
    bf16_t* dst = (bf16_t*)(P.ws + OFF_A2) + (size_t)g * 2176 * 512 + 256 + d * 128 + 2 * p;
    float sr = 0.f, si = 0.f;
    float2 xs[16];
#pragma unroll
    for (int cc = 0; cc < 16; ++cc) {
      int ci = d == 0 ? cc : 15 - cc;
      xs[cc] = *(const float2*)(sl + (size_t)(2048 + b * 16 + ci) * 256);
    }
#pragma unroll
    for (int cc = 0; cc < 16; ++cc) {
      float nr = lr_ * sr - li_ * si + xs[cc].x, ni = lr_ * si + li_ * sr + xs[cc].y;
      sr = nr; si = ni;
    }
#pragma unroll 1
    for (int c0 = 0; c0 < 256; c0 += 16) {
#pragma unroll
      for (int cc = 0; cc < 16; ++cc) {
        int c = c0 + cc;
        int ci = d == 0 ? c : 255 - c;
        xs[cc] = *(const float2*)(sl + (size_t)(b * 256 + ci) * 256);
      }
#pragma unroll
      for (int cc = 0; cc < 16; ++cc) {
        int c = c0 + cc;
        int ci = d == 0 ? c : 255 - c;
        *(unsigned*)(dst + (size_t)(b * 256 + ci) * 512) = pack2(sr, si);
        float nr = lr_ * sr - li_ * si + xs[cc].x, ni = lr_ * si + li_ * sr + xs[cc].y;
        sr = nr; si = ni;
      }
    }
  }
}

__device__ void phase_s5g2(unsigned char* smem, const Params& P) {
  const int lane = threadIdx.x & 63, wave = threadIdx.x >> 6, wm = wave >> 2, wn = wave & 3, r = lane & 15, q = lane >> 4;
  bf16_t* Y = (bf16_t*)(P.ws + OFF_YS5G);
  for (int t = blockIdx.x; t < 256; t += gridDim.x) {
    int g = t >> 3, tm = t & 7, tn = 0;
    ALin af{(const bf16_t*)(P.ws + OFF_A2) + (size_t)g * 2176 * 512, 512};
    const bf16_t* W = (const bf16_t*)(P.ws + OFF_S5WCAT) + (size_t)g * 131072;
    f32x4 acc[8][4];
    gemm_tile(smem, af, W, 256, 8, tm * 256, tn * 256, 2048, acc);
#pragma unroll
    for (int mt = 0; mt < 8; ++mt) {
      int m = tm * 256 + wm * 128 + mt * 16 + r;
#pragma unroll
      for (int nt = 0; nt < 4; ++nt) {
        int n = tn * 256 + wn * 64 + nt * 16 + 4 * q;
        f32x4 a = acc[mt][nt];
        uint2 pk; pk.x = pack2(gelu_tanh(a[0]), gelu_tanh(a[1])); pk.y = pack2(gelu_tanh(a[2]), gelu_tanh(a[3]));
        {
          const int token = m * 16 + (n >> 4), ch = n & 15;
          *(uint2*)(Y + ((size_t)(g >> 1) * 32768 + token) * 32 + (g & 1) * 16 + ch) = pk;
        }
      }
    }
  }
}

__device__ void phase_glu(unsigned char* smem, const Params& P) {
  const int lane = threadIdx.x & 63, wave = threadIdx.x >> 6, wm = wave >> 2, wn = wave & 3, r = lane & 15, q = lane >> 4;
  ABlk af{(const bf16_t*)(P.ws + OFF_YS5G), 32768};
  const bf16_t* W = (const bf16_t*)(P.ws + OFF_WTGLU);
  const float* bias = P.in[17];
  bf16_t* Y = (bf16_t*)(P.ws + OFF_YS5);
  for (int t = blockIdx.x; t < 512; t += gridDim.x) {
    int tm, tn; tile_map(t, 2, tm, tn);
    f32x4 acc[8][4];
    gemm_tile(smem, af, W, 1024, 8, tm * 256, tn * 256, 32768, acc);
    const int qq = (tn * 256 + wn * 64) >> 6;
#pragma unroll
    for (int mt = 0; mt < 8; ++mt) {
      int m = tm * 256 + wm * 128 + mt * 16 + r;
#pragma unroll
      for (int nt = 0; nt < 2; ++nt) {
        int f = 32 * qq + 16 * nt + 4 * q;
        float4 bv = *(const float4*)(bias + f), bg = *(const float4*)(bias + 512 + f);
        f32x4 va = acc[mt][nt], ga = acc[mt][nt + 2];
        float y0 = (va[0] + bv.x) / (1.0f + __expf(-(ga[0] + bg.x)));
        float y1 = (va[1] + bv.y) / (1.0f + __expf(-(ga[1] + bg.y)));
        float y2 = (va[2] + bv.z) / (1.0f + __expf(-(ga[2] + bg.z)));
        float y3 = (va[3] + bv.w) / (1.0f + __expf(-(ga[3] + bg.w)));
        uint2 pk; pk.x = pack2(y0, y1); pk.y = pack2(y2, y3);
        *(uint2*)(Y + (size_t)m * 512 + f) = pk;
      }
    }
  }
}

__device__ void phase_wout(unsigned char* smem, const Params& P) {
  const int lane = threadIdx.x & 63, wave = threadIdx.x >> 6, wm = wave >> 2, wn = wave & 3, r = lane & 15, q = lane >> 4;
  ABlk af{(const bf16_t*)(P.ws + OFF_A1), 34816};
  const bf16_t* W = (const bf16_t*)(P.ws + OFF_WTOUT);
  const float* mod = (const float*)(P.ws + OFF_MOD);
  const float* E = (const float*)(P.ws + OFF_POS);
  const float* x = P.in[0];
  for (int t = blockIdx.x; t < 512; t += gridDim.x) {
    int tm, tn; tile_map(t, 2, tm, tn);
    f32x4 acc[8][4];
    gemm_tile(smem, af, W, 1024, 16, tm * 256, tn * 256, 32768, acc);
    const int b = (tm * 256) >> 12;
    const int nb = tn * 256 + wn * 64 + 4 * q;
#pragma unroll
    for (int mt = 0; mt < 8; ++mt) {
      const int m = tm * 256 + wm * 128 + mt * 16 + r;
      const int l = m & 4095;
      float4 xv[4], ev[4];
#pragma unroll
      for (int nt = 0; nt < 4; ++nt) {
        int n = nb + nt * 16;
        xv[nt] = *(const float4*)(x + (size_t)m * 1024 + n);
        ev[nt] = n < 512 ? *(const float4*)(E + (l >> 6) * 512 + n) : *(const float4*)(E + (l & 63) * 512 + n - 512);
      }
      __builtin_amdgcn_sched_barrier(0);
#pragma unroll
      for (int nt = 0; nt < 4; ++nt) {
        int n = nb + nt * 16;
        f32x4 a = acc[mt][nt];
        float4 gt = *(const float4*)(mod + b * 6144 + 2048 + n);
        float4 o;
        o.x = xv[nt].x + ev[nt].x + gt.x * a[0]; o.y = xv[nt].y + ev[nt].y + gt.y * a[1];
        o.z = xv[nt].z + ev[nt].z + gt.z * a[2]; o.w = xv[nt].w + ev[nt].w + gt.w * a[3];
        *(float4*)(P.out + (size_t)m * 1024 + n) = o;
      }
      __builtin_amdgcn_sched_barrier(0);
    }
  }
}

__device__ void phase_mlp1(unsigned char* smem, const Params& P) {
  const int lane = threadIdx.x & 63, wave = threadIdx.x >> 6, wm = wave >> 2, wn = wave & 3, r = lane & 15, q = lane >> 4;
  ABlk af{(const bf16_t*)(P.ws + OFF_A1), 34816};
  const bf16_t* W = (const bf16_t*)(P.ws + OFF_WT1);
  bf16_t* hid = (bf16_t*)(P.ws + OFF_HID);
  unsigned char* stg = smem + wave * 9216;
  for (int t = blockIdx.x; t < 2048; t += gridDim.x) {
    int tm, tn; tile_map(t, 4, tm, tn);
    f32x4 acc[8][4];
    gemm_tile(smem, af, W, 4096, 16, tm * 256, tn * 256, 32768, acc);
#pragma unroll
    for (int half = 0; half < 2; ++half) {
#pragma unroll
      for (int mt = 0; mt < 4; ++mt) {
#pragma unroll
        for (int nt = 0; nt < 4; ++nt) {
          f32x4 a = acc[half * 4 + mt][nt];
          float r0 = fmaxf(a[0], 0.f), r1 = fmaxf(a[1], 0.f), r2 = fmaxf(a[2], 0.f), r3 = fmaxf(a[3], 0.f);
          uint2 pk; pk.x = pack2(r0 * r0, r1 * r1); pk.y = pack2(r2 * r2, r3 * r3);
          *(uint2*)(stg + (mt * 16 + r) * 144 + (nt * 16 + 4 * q) * 2) = pk;
        }
      }
      __builtin_amdgcn_sched_barrier(0);
#pragma unroll
      for (int i = 0; i < 8; ++i) {
        int row = i * 8 + (lane >> 3), chunk = lane & 7;
        uint4 v = *(const uint4*)(stg + row * 144 + chunk * 16);
        int m = tm * 256 + wm * 128 + half * 64 + row;
        *(uint4*)(hid + ((size_t)(tn * 8 + wn * 2 + (chunk >> 2)) * 32768 + m) * 32 + (chunk & 3) * 8) = v;
      }
      __builtin_amdgcn_sched_barrier(0);
    }
    __syncthreads();
  }
}

__device__ void phase_mlp2(unsigned char* smem, const Params& P) {
  const int lane = threadIdx.x & 63, wave = threadIdx.x >> 6, wm = wave >> 2, wn = wave & 3, r = lane & 15, q = lane >> 4;
  ABlk af{(const bf16_t*)(P.ws + OFF_HID), 32768};
  const bf16_t* W = (const bf16_t*)(P.ws + OFF_WT2);
  const float* mod = (const float*)(P.ws + OFF_MOD);
  for (int t = blockIdx.x; t < 512; t += gridDim.x) {
    int tm, tn; tile_map(t, 2, tm, tn);
    f32x4 acc[8][4];
    gemm_tile(smem, af, W, 1024, 64, tm * 256, tn * 256, 32768, acc);
    const int b = (tm * 256) >> 12;
    const int nb = tn * 256 + wn * 64 + 4 * q;
    float4 gt[4];
#pragma unroll
    for (int nt = 0; nt < 4; ++nt) gt[nt] = *(const float4*)(mod + b * 6144 + 5120 + nb + nt * 16);
#pragma unroll
    for (int mp = 0; mp < 4; ++mp) {
      float4 o[2][4];
#pragma unroll
      for (int h = 0; h < 2; ++h)
#pragma unroll
        for (int nt = 0; nt < 4; ++nt) {
          int m = tm * 256 + wm * 128 + (mp * 2 + h) * 16 + r;
          o[h][nt] = *(const float4*)(P.out + (size_t)m * 1024 + nb + nt * 16);
        }
      __builtin_amdgcn_sched_barrier(0);
#pragma unroll
      for (int h = 0; h < 2; ++h)
#pragma unroll
        for (int nt = 0; nt < 4; ++nt) {
          int m = tm * 256 + wm * 128 + (mp * 2 + h) * 16 + r;
          f32x4 a = acc[mp * 2 + h][nt];
          float4 v = o[h][nt];
          v.x += gt[nt].x * a[0]; v.y += gt[nt].y * a[1]; v.z += gt[nt].z * a[2]; v.w += gt[nt].w * a[3];
          *(float4*)(P.out + (size_t)m * 1024 + nb + nt * 16) = v;
        }
      __builtin_amdgcn_sched_barrier(0);
    }
  }
}

__device__ void phase_mixnorm(unsigned char* smem, const Params& P) {
  const int tid = threadIdx.x, lane = tid & 63, wave = tid >> 6;
  bf16_t* hyT = (bf16_t*)smem;
  const bf16_t* Z = (const bf16_t*)(P.ws + OFF_Z);
  const bf16_t* Ys5 = (const bf16_t*)(P.ws + OFF_YS5);
  bf16_t* mix = (bf16_t*)(P.ws + OFF_A1);
  for (int tile = blockIdx.x; tile < 512; tile += gridDim.x) {
    int b = tile >> 6, l0 = (tile & 63) * 64;
    {
      const uint4* src = (const uint4*)(Z + ((size_t)(tid * 8 + b)) * 4096 + l0);
      unsigned* drow = (unsigned*)(hyT + tid * 66);
#pragma unroll
      for (int i = 0; i < 8; ++i) {
        uint4 v = src[i];
        drow[i * 4 + 0] = v.x; drow[i * 4 + 1] = v.y; drow[i * 4 + 2] = v.z; drow[i * 4 + 3] = v.w;
      }
    }
    __syncthreads();
#pragma unroll 1
    for (int hh = 0; hh < 2; ++hh) {
      uint4 svp[4];
#pragma unroll
      for (int i = 0; i < 4; ++i) svp[i] = *(const uint4*)(Ys5 + ((size_t)b * 4096 + l0 + wave * 8 + hh * 4 + i) * 512 + lane * 8);
#pragma unroll
      for (int ti = 0; ti < 4; ++ti) {
        const int tt = wave * 8 + hh * 4 + ti;
        size_t token = (size_t)b * 4096 + l0 + tt;
      uint4 sv = svp[ti];
      float s[8];
      s[0] = bf2f(sv.x & 0xffff); s[1] = bf2f(sv.x >> 16); s[2] = bf2f(sv.y & 0xffff); s[3] = bf2f(sv.y >> 16);
      s[4] = bf2f(sv.z & 0xffff); s[5] = bf2f(sv.z >> 16); s[6] = bf2f(sv.w & 0xffff); s[7] = bf2f(sv.w >> 16);
      float h[8];
      float ss5 = 0.f, ssh = 0.f;
#pragma unroll
      for (int i = 0; i < 8; ++i) {
        h[i] = bf2f(hyT[(2 * lane + 128 * (i >> 1) + (i & 1)) * 66 + tt]);
        ss5 += s[i] * s[i]; ssh += h[i] * h[i];
      }
      ss5 = wave_sum(ss5); ssh = wave_sum(ssh);
      float r5 = rsqrtf(ss5 * (1.0f / 512.0f) + 1e-6f), rh = rsqrtf(ssh * (1.0f / 512.0f) + 1e-6f);
      uint4 o;
      o.x = pack2(s[0] * r5, s[1] * r5); o.y = pack2(s[2] * r5, s[3] * r5);
      o.z = pack2(s[4] * r5, s[5] * r5); o.w = pack2(s[6] * r5, s[7] * r5);
      *(uint4*)(mix + ((size_t)(lane >> 2) * 34816 + token) * 32 + (lane & 3) * 8) = o;
#pragma unroll
      for (int i = 0; i < 4; ++i) {
        const int c = 2 * lane + 128 * i;
        *(unsigned*)(mix + ((size_t)(16 + (c >> 5)) * 34816 + token) * 32 + (c & 31)) = pack2(h[2 * i] * rh, h[2 * i + 1] * rh);
      }
          }
    }
    __syncthreads();
  }
}

__device__ __forceinline__ constexpr int SW(int i) { return i ^ ((i >> 3) & 31); }
#define DSW(PTR, TYPE, SWB8, C) (*(TYPE*)((unsigned char*)(PTR) + ((SWB8) ^ (SW(C) << 3))))

typedef float v2f __attribute__((ext_vector_type(2)));
#define C16(k) (C16_TAB[(k) & 15])
#define S16(k) (S16_TAB[(k) & 15])
__device__ constexpr float C16_TAB[16] = {1.000000000e+00f, 9.238795325e-01f, 7.071067812e-01f, 3.826834324e-01f, 6.123233996e-17f, -3.826834324e-01f, -7.071067812e-01f, -9.238795325e-01f, -1.000000000e+00f, -9.238795325e-01f, -7.071067812e-01f, -3.826834324e-01f, -1.836970199e-16f, 3.826834324e-01f, 7.071067812e-01f, 9.238795325e-01f};
__device__ constexpr float S16_TAB[16] = {0.000000000e+00f, 3.826834324e-01f, 7.071067812e-01f, 9.238795325e-01f, 1.000000000e+00f, 9.238795325e-01f, 7.071067812e-01f, 3.826834324e-01f, 1.224646799e-16f, -3.826834324e-01f, -7.071067812e-01f, -9.238795325e-01f, -1.000000000e+00f, -9.238795325e-01f, -7.071067812e-01f, -3.826834324e-01f};

struct TwBase { float c[4], s[4]; };
template <int S0>
__device__ __forceinline__ TwBase make_twbase(int lo) {
  TwBase t;
  float rev = (float)lo * (1.0f / (float)(1 << (13 - S0)));
  t.c[0] = cosrev(rev); t.s[0] = sinrev(rev);
#pragma unroll
  for (int u = 1; u < 4; ++u) { t.c[u] = t.c[u - 1] * t.c[u - 1] - t.s[u - 1] * t.s[u - 1]; t.s[u] = 2.0f * t.c[u - 1] * t.s[u - 1]; }
  return t;
}
template <int NS, int S0, bool INV, bool TOKS = false>
__device__ __forceinline__ void fft_pass(float2* Df, int tid0, float2* KSout = nullptr, const TwBase* twb = nullptr) {
  v2f* D = (v2f*)Df;
  constexpr int R = 1 << NS;
  constexpr int pos = 13 - S0 - NS;
#pragma unroll 1
  for (int tix = tid0; tix < (8192 >> NS); tix += NT) {
    const int lo = tix & ((1 << pos) - 1), hi = tix >> pos;
    const int base = (hi << (pos + NS)) | lo;
    v2f v[R];
    const int swb8 = SW(base) << 3;
#pragma unroll
    for (int e = 0; e < R; ++e) v[e] = DSW(D, v2f, swb8, e << pos);
    float tc[NS], ts[NS];
    if (twb) {
#pragma unroll
      for (int u = 0; u < NS; ++u) { tc[u] = twb->c[u]; ts[u] = twb->s[u]; asm volatile("" : "+v"(tc[u]), "+v"(ts[u])); }
    } else {
      float rev = (float)lo * (1.0f / (float)(1 << (13 - S0)));
      tc[0] = cosrev(rev); ts[0] = sinrev(rev);
#pragma unroll
      for (int u = 1; u < NS; ++u) { tc[u] = tc[u - 1] * tc[u - 1] - ts[u - 1] * ts[u - 1]; ts[u] = 2.0f * tc[u - 1] * ts[u - 1]; }
    }
    if (!INV) {
#pragma unroll
      for (int u = 0; u < NS; ++u) {
        const int bit = 1 << (NS - 1 - u);
#pragma unroll
        for (int e = 0; e < R; ++e) {
          if (e & bit) continue;
          const int k16 = (e & (bit - 1)) << (4 - NS + u);
          float c, sn;
          if (k16 == 0) { c = tc[u]; sn = ts[u]; }
          else if (k16 == 4) { c = -ts[u]; sn = tc[u]; }
          else { c = tc[u] * C16(k16) - ts[u] * S16(k16); sn = ts[u] * C16(k16) + tc[u] * S16(k16); }
          v2f a = v[e], bb = v[e | bit];
          v2f d = a - bb;
          v[e] = a + bb;
          v2f t1 = d * (v2f){c, c};
          v[e | bit] = __builtin_elementwise_fma((v2f){d.y, d.x}, (v2f){sn, -sn}, t1);
        }
      }
    } else {
#pragma unroll
      for (int u = NS - 1; u >= 0; --u) {
        const int bit = 1 << (NS - 1 - u);
#pragma unroll
        for (int e = 0; e < R; ++e) {
          if (e & bit) continue;
          const int k16 = (e & (bit - 1)) << (4 - NS + u);
          float c, sn;
          if (k16 == 0) { c = tc[u]; sn = ts[u]; }
          else if (k16 == 4) { c = -ts[u]; sn = tc[u]; }
          else { c = tc[u] * C16(k16) - ts[u] * S16(k16); sn = ts[u] * C16(k16) + tc[u] * S16(k16); }
          v2f a = v[e], bb = v[e | bit];
          v2f t1 = bb * (v2f){c, c};
          v2f t = __builtin_elementwise_fma((v2f){bb.y, bb.x}, (v2f){-sn, sn}, t1);
          v[e] = a + t;
          v[e | bit] = a - t;
        }
      }
    }
#pragma unroll
    for (int e = 0; e < R; ++e) {
      if (TOKS) DSW(KSout, v2f, swb8, e << pos) = v[e] * (v2f){1.0f / 8192.0f, 1.0f / 8192.0f};
      else DSW(D, v2f, swb8, e << pos) = v[e];
    }
  }
}

__device__ __forceinline__ int opaque_tid_fwd() {
  int t = threadIdx.x;
  asm volatile("" : "+v"(t));
  return t;
}
__device__ __forceinline__ void fft_mid(float2* Df, const float2* KSf, int tid0) {
  v2f* D = (v2f*)Df;
  const v2f* KS = (const v2f*)KSf;
  const int base = tid0 << 4;
  v2f v[16];
  const int swb8 = SW(base) << 3;
#pragma unroll
  for (int e = 0; e < 16; ++e) v[e] = DSW(D, v2f, swb8, e);
#pragma unroll
  for (int u = 0; u < 4; ++u) {
    const int bit = 1 << (3 - u);
    const float scale = 1.0f / (float)(1 << (4 - u));
#pragma unroll
    for (int e = 0; e < 16; ++e) {
      if (e & bit) continue;
      const int k16 = (e & (bit - 1)) << u;
      const float c = C16(k16), sn = S16(k16);
      v2f a = v[e], bb = v[e | bit];
      v2f d = a - bb;
      v[e] = a + bb;
      if (k16 == 0) v[e | bit] = d;
      else if (k16 == 4) v[e | bit] = (v2f){d.y, -d.x};
      else {
        v2f t1 = d * (v2f){c, c};
        v[e | bit] = __builtin_elementwise_fma((v2f){d.y, d.x}, (v2f){sn, -sn}, t1);
      }
    }
  }
#pragma unroll
  for (int e = 0; e < 16; ++e) {
    v2f k = DSW(KS, const v2f, swb8, e);
    v2f a = v[e];
    v2f t1 = a * (v2f){k.x, k.x};
    v[e] = __builtin_elementwise_fma((v2f){a.y, a.x}, (v2f){-k.y, k.y}, t1);
  }
#pragma unroll
  for (int u = 3; u >= 0; --u) {
    const int bit = 1 << (3 - u);
    const float scale = 1.0f / (float)(1 << (4 - u));
#pragma unroll
    for (int e = 0; e < 16; ++e) {
      if (e & bit) continue;
      const int k16 = (e & (bit - 1)) << u;
      const float c = C16(k16), sn = S16(k16);
      v2f a = v[e], bb = v[e | bit];
      v2f t;
      if (k16 == 0) t = bb;
      else if (k16 == 4) t = (v2f){-bb.y, bb.x};
      else {
        v2f t1 = bb * (v2f){c, c};
        t = __builtin_elementwise_fma((v2f){bb.y, bb.x}, (v2f){-sn, sn}, t1);
      }
      v[e] = a + t;
      v[e | bit] = a - t;
    }
  }
#pragma unroll
  for (int e = 0; e < 16; ++e) DSW(D, v2f, swb8, e) = v[e];
}
__device__ __forceinline__ int opaque_tid() {
  int t = threadIdx.x;
  asm volatile("" : "+v"(t));
  return t;
}
__device__ __forceinline__ void fft_conv(float2* D, const float2* KS, const TwBase& tw1, const TwBase& tw5) {
  const int t = opaque_tid();
  fft_pass<4, 1, false>(D, t, nullptr, &tw1); __syncthreads();
  fft_pass<4, 5, false>(D, t, nullptr, &tw5); __syncthreads();
  fft_mid(D, KS, t); __syncthreads();
  fft_pass<4, 5, true>(D, t, nullptr, &tw5); __syncthreads();
  fft_pass<4, 1, true>(D, t, nullptr, &tw1); __syncthreads();
}
__device__ __forceinline__ void fft_fwd(float2* D, float2* KS, const TwBase& tw1, const TwBase& tw5) {
  const int t = opaque_tid();
  fft_pass<4, 1, false>(D, t, nullptr, &tw1); __syncthreads();
  fft_pass<4, 5, false>(D, t, nullptr, &tw5); __syncthreads();
  fft_pass<4, 9, false, true>(D, t, KS); __syncthreads();
}

#define LOAD8(X, ROW, T)                                                          \
  float X##0, X##1, X##2, X##3, X##4, X##5, X##6, X##7, X##8, X##9;               \
  {                                                                               \
    const bf16_t* rw_ = (ROW);                                                    \
    uint4 v_ = *(const uint4*)(rw_ + 8 * (T));                                    \
    X##0 = (T) > 0 ? bf2f(rw_[8 * (T)-1]) : 0.f;                                  \
    X##9 = (T) < 511 ? bf2f(rw_[8 * (T) + 8]) : 0.f;                              \
    X##1 = bf2f(v_.x & 0xffff); X##2 = bf2f(v_.x >> 16);                          \
    X##3 = bf2f(v_.y & 0xffff); X##4 = bf2f(v_.y >> 16);                          \
    X##5 = bf2f(v_.z & 0xffff); X##6 = bf2f(v_.z >> 16);                          \
    X##7 = bf2f(v_.w & 0xffff); X##8 = bf2f(v_.w >> 16);                          \
  }
#define SC3(XM, X0, XP, W0, W1, W2, B) ((XM) * (W0) + (X0) * (W1) + (XP) * (W2) + (B))

#define LD_ST(E, XM, X0, XP, YM, Y0, YP)                                                   \
          {                                                                               \
            float a0_ = SC3(XM, X0, XP, ua, ub, uc, ud), a1_ = SC3(YM, Y0, YP, ua, ub, uc, ud); \
            float rv_ = (float)(i0 + (E)) * (1.0f / 8192.0f);                             \
            float c_ = cosrev(rv_), s_ = sinrev(rv_);                                     \
            DSW(D, float2, sw0, (E)) = make_float2(a0_, a1_);                                \
            DSW(D + 4096, float2, sw0, (E)) = make_float2(a0_ * c_ + a1_ * s_, a1_ * c_ - a0_ * s_); \
          }
#define RD_Y(E)                                                                           \
          float2 y##E;                                                                    \
          {                                                                               \
            float2 A_ = DSW(D, float2, sw0, (E)), B_ = DSW(D + 4096, float2, sw0, (E));     \
            float rv_ = (float)(i0 + (E)) * (1.0f / 8192.0f);                             \
            float c_ = cosrev(rv_), s_ = sinrev(rv_);                                     \
            y##E = make_float2(A_.x + B_.x * c_ - B_.y * s_, A_.y + B_.x * s_ + B_.y * c_); \
          }
#define OUTA(E, XM, X0, XP, GM, G0, GP) (SC3(GM, G0, GP, wg0, wg1, wg2, bg) * (y##E.x + bias * SC3(XM, X0, XP, ua, ub, uc, ud)))
#define OUTB(E, XM, X0, XP, GM, G0, GP) (SC3(GM, G0, GP, wg0, wg1, wg2, bg) * (y##E.y + bias * SC3(XM, X0, XP, ua, ub, uc, ud)))
__device__ void phase_hyena(unsigned char* smem, const Params& P) {
  const int tid = threadIdx.x;
  float2* D = (float2*)smem;
  float2* KS = D + 8192;
  bf16_t* Z = (bf16_t*)(P.ws + OFF_Z);
  bf16_t* Z1 = (bf16_t*)(P.ws + OFF_Z1);
  const float* filt = (const float*)(P.ws + OFF_FILT);
  const float* cw = P.in[18]; const float* cb = P.in[19]; const float* hbias = P.in[27];
  const TwBase tw1 = make_twbase<1>(tid & 255), tw5 = make_twbase<5>(tid & 15);
#pragma unroll 1
  for (int c = blockIdx.x; c < 512; c += gridDim.x) {
    bf16_t* Zv = Z + (size_t)c * 8 * 4096;
    bf16_t* Zm = Z1 + (size_t)c * 8 * 4096;
    const float wv0 = cw[c], wv1 = cw[1536 + c], wv2 = cw[3072 + c], bv = cb[c];
#pragma unroll 1
    for (int order = 0; order < 2; ++order) {
      const float* hf = filt + ((size_t)((order * 2 + 0) * 512 + c)) * 4096;
      const float* hb = filt + ((size_t)((order * 2 + 1) * 512 + c)) * 4096;
#pragma unroll 2
      for (int i = tid; i < 4096; i += NT) {
        const float lo_v = hf[i];
        const float up_v = i == 0 ? 0.f : hb[4096 - i];
        const float a = lo_v + up_v, d = lo_v - up_v;
        const float rv = (float)i * (1.0f / 8192.0f);
        D[SW(i)] = make_float2(a, 0.f);
        D[SW(i + 4096)] = make_float2(d * cosrev(rv), -d * sinrev(rv));
      }
      __syncthreads();
      fft_fwd(D, KS, tw1, tw5);
      const int cgi = (order == 0 ? 512 : 1024) + c;
      const bf16_t* Zg = Z + (size_t)cgi * 8 * 4096;
      const float wg0 = cw[cgi], wg1 = cw[1536 + cgi], wg2 = cw[3072 + cgi], bg = cb[cgi];
      const float bias = hbias[order * 512 + c];
      const float ua = order == 0 ? wv0 : 0.f, ub = order == 0 ? wv1 : 1.f, uc = order == 0 ? wv2 : 0.f, ud = order == 0 ? bv : 0.f;
#define RAW_LOAD(R, ROW, T)                                              \
      {                                                                      \
        const bf16_t* rw_ = (ROW);                                           \
        R##v = *(const uint4*)(rw_ + 8 * (T));                               \
        R##p = (T) > 0 ? rw_[8 * (T)-1] : (bf16_t)0;                         \
        R##n = (T) < 511 ? rw_[8 * (T) + 8] : (bf16_t)0;                     \
      }
#define RAW_UNPACK(X, R)                                                     \
      const float X##0 = bf2f(R##p), X##9 = bf2f(R##n),                      \
                  X##1 = bf2f(R##v.x & 0xffff), X##2 = bf2f(R##v.x >> 16),   \
                  X##3 = bf2f(R##v.y & 0xffff), X##4 = bf2f(R##v.y >> 16),   \
                  X##5 = bf2f(R##v.z & 0xffff), X##6 = bf2f(R##v.z >> 16),   \
                  X##7 = bf2f(R##v.w & 0xffff), X##8 = bf2f(R##v.w >> 16);
      const bf16_t* rin = (order == 0 ? Zv : Zm);
      uint4 rav, rbv, rgv, rhv; bf16_t rap, ran, rbp, rbn, rgp, rgn, rhp, rhn;
      RAW_LOAD(ra, rin, tid)
      RAW_LOAD(rb, rin + 4096, tid)
#pragma unroll 1
      for (int pair = 0; pair < 4; ++pair) {
        const uint4 sav = rav, sbv = rbv; const bf16_t sap = rap, san = ran, sbp = rbp, sbn = rbn;
        {
          RAW_UNPACK(xa, ra)
          RAW_UNPACK(xb, rb)
          int i0 = 8 * tid;
          asm volatile("" : "+v"(i0));
          const int sw0 = SW(i0) << 3;
          LD_ST(0, xa0, xa1, xa2, xb0, xb1, xb2)
          LD_ST(1, xa1, xa2, xa3, xb1, xb2, xb3)
          LD_ST(2, xa2, xa3, xa4, xb2, xb3, xb4)
          LD_ST(3, xa3, xa4, xa5, xb3, xb4, xb5)
          LD_ST(4, xa4, xa5, xa6, xb4, xb5, xb6)
          LD_ST(5, xa5, xa6, xa7, xb5, xb6, xb7)
          LD_ST(6, xa6, xa7, xa8, xb6, xb7, xb8)
          LD_ST(7, xa7, xa8, xa9, xb7, xb8, xb9)
        }
        RAW_LOAD(rg, Zg + (size_t)(2 * pair) * 4096, tid)
        RAW_LOAD(rh, Zg + (size_t)(2 * pair + 1) * 4096, tid)
        {
          const int np = pair < 3 ? pair + 1 : pair;
          RAW_LOAD(ra, rin + (size_t)(2 * np) * 4096, tid)
          RAW_LOAD(rb, rin + (size_t)(2 * np + 1) * 4096, tid)
        }
        __syncthreads();
        fft_conv(D, KS, tw1, tw5);
        {
          bf16_t* o0 = (order == 0 ? Zm : Zv) + (size_t)(2 * pair) * 4096;
          bf16_t* o1 = o0 + 4096;
          RAW_UNPACK(ga, rg)
          RAW_UNPACK(gb, rh)
          RAW_UNPACK(xa, sa)
          RAW_UNPACK(xb, sb)
          int i0 = 8 * tid;
          asm volatile("" : "+v"(i0));
          const int sw0 = SW(i0) << 3;
          RD_Y(0) RD_Y(1) RD_Y(2) RD_Y(3) RD_Y(4) RD_Y(5) RD_Y(6) RD_Y(7)
          uint4 pa, pb;
          pa.x = pack2(OUTA(0, xa0, xa1, xa2, ga0, ga1, ga2), OUTA(1, xa1, xa2, xa3, ga1, ga2, ga3));
          pa.y = pack2(OUTA(2, xa2, xa3, xa4, ga2, ga3, ga4), OUTA(3, xa3, xa4, xa5, ga3, ga4, ga5));
          pa.z = pack2(OUTA(4, xa4, xa5, xa6, ga4, ga5, ga6), OUTA(5, xa5, xa6, xa7, ga5, ga6, ga7));
          pa.w = pack2(OUTA(6, xa6, xa7, xa8, ga6, ga7, ga8), OUTA(7, xa7, xa8, xa9, ga7, ga8, ga9));
          pb.x = pack2(OUTB(0, xb0, xb1, xb2, gb0, gb1, gb2), OUTB(1, xb1, xb2, xb3, gb1, gb2, gb3));
          pb.y = pack2(OUTB(2, xb2, xb3, xb4, gb2, gb3, gb4), OUTB(3, xb3, xb4, xb5, gb3, gb4, gb5));
          pb.z = pack2(OUTB(4, xb4, xb5, xb6, gb4, gb5, gb6), OUTB(5, xb5, xb6, xb7, gb5, gb6, gb7));
          pb.w = pack2(OUTB(6, xb6, xb7, xb8, gb6, gb7, gb8), OUTB(7, xb7, xb8, xb9, gb7, gb8, gb9));
          *(uint4*)(o0 + i0) = pa;
          *(uint4*)(o1 + i0) = pb;
        }
        __syncthreads();
      }
    }
  }
}


#define XB_TMO      128
#define XB_XCNT(j)  (256  + 64 * (j))
#define XB_XSUB(j)  (1280 + 64 * (j))
#define XB_XGEN(j)  (2304 + 64 * (j))
#define XB_TOP      3328
#define XB_TOPGEN   3392
#define XCD_BAR_WORDS 3456
#define XB_SPIN_CAP (1u << 18)
#define LAS __attribute__((address_space(3)))
__device__ __forceinline__ unsigned xb_ld(unsigned* p) { return __hip_atomic_load(p, __ATOMIC_RELAXED, __HIP_MEMORY_SCOPE_AGENT); }
__device__ __forceinline__ unsigned xb_add(unsigned* p, unsigned v) { return __hip_atomic_fetch_add(p, v, __ATOMIC_RELAXED, __HIP_MEMORY_SCOPE_AGENT); }
__device__ __forceinline__ unsigned xb_xcc_id() { return (unsigned)__builtin_amdgcn_s_getreg((3 << 11) | 20) & 0xFu; }
#define XB_SPIN(cond, bar) do { unsigned _sp = 0; while (cond) { __builtin_amdgcn_s_sleep(1); \
    if ((++_sp & 255u) == 0u) { if (xb_ld(&(bar)[XB_TMO])) break; if (_sp > XB_SPIN_CAP) { atomicAdd(&(bar)[XB_TMO], 1u); break; } } } } while (0)
struct XcdBarrier { unsigned* bar; unsigned x; volatile LAS unsigned* st; };
__device__ __forceinline__ XcdBarrier xcd_barrier_post(unsigned* bar, volatile LAS unsigned* st) {
  XcdBarrier b; b.bar = bar; b.x = xb_xcc_id(); b.st = st;
  if (threadIdx.x == 0) (void)xb_add(&bar[XB_XCNT(b.x)], 1u);
  return b;
}
__device__ __forceinline__ void xcd_barrier_complete(unsigned* bar, unsigned x, unsigned& nloc, unsigned& nx) {
  const unsigned G = gridDim.x * gridDim.y * gridDim.z;
  unsigned sum, cnt, mine, sp = 0u;
  for (;;) {
    sum = 0u; cnt = 0u; mine = 0u;
#pragma unroll
    for (unsigned j = 0; j < 16; ++j) { const unsigned c = xb_ld(&bar[XB_XCNT(j)]); sum += c; cnt += (c > 0u) ? 1u : 0u; mine = (j == x) ? c : mine; }
    if (sum == G) break;
    __builtin_amdgcn_s_sleep(1);
    if ((++sp & 255u) == 0u) { if (xb_ld(&bar[XB_TMO])) break; if (sp > XB_SPIN_CAP) { atomicAdd(&bar[XB_TMO], 1u); break; } }
  }
  nloc = mine > 0u ? mine : 1u; nx = cnt > 0u ? cnt : 1u;
}
__device__ __forceinline__ void xcd_barrier(unsigned* bar_, volatile LAS unsigned* st_) {
  asm volatile("s_waitcnt vmcnt(0)" ::: "memory");
  __syncthreads();
  if (threadIdx.x == 0) {
    XcdBarrier b; b.bar = bar_; b.x = xb_xcc_id(); b.st = st_;
    unsigned* bar = b.bar;
    __builtin_amdgcn_s_waitcnt(0);
    unsigned nloc = b.st[0], nx = b.st[1];
    if (nloc == 0u) { xcd_barrier_complete(bar, b.x, nloc, nx); b.st[0] = nloc; b.st[1] = nx; }
    const unsigned old = xb_add(&bar[XB_XSUB(b.x)], 1u);
    const unsigned gen = old / nloc;
    if (old + 1u == (gen + 1u) * nloc) {
      __builtin_amdgcn_fence(__ATOMIC_RELEASE, "agent");
      asm volatile("s_waitcnt vmcnt(0)" ::: "memory");
      const unsigned og = xb_add(&bar[XB_TOP], 1u);
      const unsigned tg = og / nx;
      if (og + 1u == (tg + 1u) * nx) xb_add(&bar[XB_TOPGEN], 1u);
      else XB_SPIN(xb_ld(&bar[XB_TOPGEN]) == tg, bar);
      __builtin_amdgcn_fence(__ATOMIC_ACQUIRE, "agent");
      xb_add(&bar[XB_XGEN(b.x)], 1u);
      asm volatile("s_waitcnt vmcnt(0)" ::: "memory");
    } else {
      XB_SPIN(xb_ld(&bar[XB_XGEN(b.x)]) == gen, bar);
      __builtin_amdgcn_fence(__ATOMIC_ACQUIRE, "agent");
      asm volatile("s_waitcnt vmcnt(0)" ::: "memory");
    }
  }
  __syncthreads();
}

#define PHASE(k, call)                                   \
  {                                                        \
    if ((k) == 1) grid.sync();                             \
    else if ((k) > 1) xcd_barrier((unsigned*)(P.ws + OFF_BAR), (volatile LAS unsigned*)(smem + 131072)); \
    call;                                                  \
  }
__global__ void __launch_bounds__(NT) fwd_kernel(Params P) {
  extern __shared__ __attribute__((aligned(16))) unsigned char smem[];
  cg::grid_group grid = cg::this_grid();
  volatile LAS unsigned* xst = (volatile LAS unsigned*)(smem + 131072);
  if (threadIdx.x < 2) xst[threadIdx.x] = 0u;
  __syncthreads();
  (void)xcd_barrier_post((unsigned*)(P.ws + OFF_BAR), xst);
  PHASE(0, phase0(smem, P))
  PHASE(1, phase_rownorm(P, 3); xcd_barrier((unsigned*)(P.ws + OFF_BAR), (volatile LAS unsigned*)(smem + 131072));
           if (blockIdx.x < 16) phase_gemm1(smem, P, 1); else phase_rownorm(P, 0))
  PHASE(2, phase_gemm1(smem, P, 0))
  PHASE(3, phase_s5g1(smem, P))
  PHASE(4, phase_s5scan(P))
  PHASE(5, phase_s5g2(smem, P))
  PHASE(6, phase_glu(smem, P); phase_hyena(smem, P))
  PHASE(8, phase_mixnorm(smem, P))
  PHASE(9, phase_wout(smem, P))
  PHASE(10, phase_rownorm(P, 1))
  PHASE(11, phase_mlp1(smem, P))
  PHASE(12, phase_mlp2(smem, P))
  PHASE(13, phase_rownorm(P, 2))
}

extern "C" void kernel_launch(void* const* d_in, const int* in_sizes, int n_in, void* d_out, int out_size, void* d_ws,
                              size_t ws_size, hipStream_t stream) {
  static int grid_blocks = 0;
  if (!grid_blocks) {
    int dev = 0, cus = 0, per_cu = 0;
    (void)hipGetDevice(&dev);
    (void)hipDeviceGetAttribute(&cus, hipDeviceAttributeMultiprocessorCount, dev);
    (void)hipFuncSetAttribute((const void*)fwd_kernel, hipFuncAttributeMaxDynamicSharedMemorySize, LDS_BYTES);
    (void)hipOccupancyMaxActiveBlocksPerMultiprocessor(&per_cu, (const void*)fwd_kernel, NT, LDS_BYTES);
    if (per_cu < 1) per_cu = 1;
    if (cus < 1) cus = 256;
    grid_blocks = cus * per_cu;
    (void)hipGetLastError();
  }
  if (n_in != 35 || ws_size < WS_NEED) {
    fprintf(stderr, "kernel_launch: unexpected n_in %d or ws_size %zu\n", n_in, ws_size);
    return;
  }
  Params p;
  memset(&p, 0, sizeof(p));
  for (int i = 0; i < 35; ++i) p.in[i] = (const float*)d_in[i];
  p.out = (float*)d_out;
  p.ws = (unsigned char*)d_ws;
  (void)hipMemsetAsync((unsigned char*)d_ws + OFF_BAR, 0, XCD_BAR_WORDS * sizeof(unsigned), stream);
  p.ph_lo = 0; p.ph_hi = N_PHASES;
  void* args[] = {&p};
  hipError_t e = hipLaunchCooperativeKernel((const void*)fwd_kernel, dim3(grid_blocks), dim3(NT), args, LDS_BYTES, stream);
  if (e != hipSuccess) fprintf(stderr, "cooperative launch failed: %s (grid %d)\n", hipGetErrorString(e), grid_blocks);
}
```

```cpp
#include <hip/hip_runtime.h>
#include <hip/hip_cooperative_groups.h>
#include <stdint.h>
#include <stdio.h>
#include <string.h>
namespace cg = cooperative_groups;

#define NT 512
#define LDS_BYTES (131072 + 16)
#define N_PHASES 14
#ifndef MULTI_LAUNCH
#define MULTI_LAUNCH 0
#endif

typedef unsigned short bf16_t;
using bf16x8 = __attribute__((ext_vector_type(8))) short;
using f32x4 = __attribute__((ext_vector_type(4))) float;

#define MiB ((size_t)1 << 20)
#define OFF_WTIN (0 * MiB)
#define OFF_WTGLU (4 * MiB)
#define OFF_WTOUT (5 * MiB)
#define OFF_WT1 (7 * MiB)
#define OFF_WT2 (15 * MiB)
#define OFF_S5WIN (23 * MiB)
#define OFF_S5WCAT (27 * MiB)
#define OFF_MOD (35 * MiB)
#define OFF_POS (36 * MiB)
#define OFF_A1 (37 * MiB)
#define OFF_YS5 (105 * MiB)
#define OFF_A2 (137 * MiB)
#define OFF_SLOC (205 * MiB)
#define OFF_Z (273 * MiB)
#define OFF_FILT (369 * MiB)
#define OFF_YS5G (401 * MiB)
#define OFF_HID (137 * MiB)
#define OFF_Z1 (433 * MiB)
#define OFF_BAR (465 * MiB)
#define WS_NEED (466 * MiB)

struct Params {
  const float* in[35];
  float* out;
  unsigned char* ws;
  int ph_lo, ph_hi;
};

__device__ __forceinline__ unsigned short f2bf(float f) {
  unsigned u = __float_as_uint(f);
  u += 0x7fffu + ((u >> 16) & 1u);
  return (unsigned short)(u >> 16);
}
__device__ __forceinline__ float bf2f(unsigned short h) { return __uint_as_float(((unsigned)h) << 16); }
__device__ __forceinline__ unsigned pack2(float a, float b) { return (unsigned)f2bf(a) | ((unsigned)f2bf(b) << 16); }
__device__ __forceinline__ float sinrev(float r) { return __builtin_amdgcn_sinf(r); }
__device__ __forceinline__ float cosrev(float r) { return __builtin_amdgcn_cosf(r); }
#define INV2PI 0.15915494309189535f
__device__ __forceinline__ float hsin(float x) { return __builtin_amdgcn_sinf(x * INV2PI); }
__device__ __forceinline__ float hcos(float x) { return __builtin_amdgcn_cosf(x * INV2PI); }
__device__ __forceinline__ float wave_sum(float v) {
#pragma unroll
  for (int o = 32; o >= 1; o >>= 1) v += __shfl_xor(v, o, 64);
  return v;
}
__device__ __forceinline__ float gelu_tanh(float x) {
  float z = 0.7978845608028654f * (x + 0.044715f * x * x * x);
  float e = __expf(2.0f * z);
  float t = 1.0f - 2.0f / (e + 1.0f);
  return 0.5f * x * (1.0f + t);
}

struct ALin {
  const bf16_t* p; int ld;
  __device__ __forceinline__ const bf16_t* operator()(int m, int k) const { return p + (unsigned)(m * ld + k); }
};
struct ABlk {
  const bf16_t* p; int M;
  __device__ __forceinline__ const bf16_t* operator()(int m, int k) const {
    return p + (unsigned)(((k >> 5) * M + m) * 32 + (k & 31));
  }
};
struct AGlu {
  const bf16_t* p;
  __device__ __forceinline__ const bf16_t* operator()(int m, int k) const {
    return p + (unsigned)(((k >> 4) * 32768 + m) * 16 + (k & 15));
  }
};

#define G_DMA(STEP, STAGE_OFF)                                                                     \
  {                                                                                                \
    const int s_ = min((STEP), ns - 1);                                                            \
    _Pragma("unroll") for (int i = 0; i < 4; ++i) {                                                \
      const int p_ = wave * 4 + i;                                                                 \
      const bf16_t* g_;                                                                            \
      if (wave < 4) g_ = af(min(m0 + p_ * 16 + (lane >> 2), mmax - 1), s_ * 32 + dchunk * 8);      \
      else g_ = W + (unsigned)((s_ * ldw + n0 + (p_ - 16) * 16 + (lane >> 2)) * 32 + dchunk * 8); \
      __builtin_amdgcn_global_load_lds((const unsigned*)g_, (unsigned*)(smem + (STAGE_OFF) + p_ * 1024 + lane * 16), 16, 0, 0); \
    }                                                                                              \
  }
#define G_READ_LO(OFF, FAL)                                                                        \
  {                                                                                                \
    const unsigned char* pa_ = smem + (OFF) + rdA_off;                                             \
    _Pragma("unroll") for (int mt = 0; mt < 4; ++mt) FAL[mt] = *(const bf16x8*)(pa_ + mt * 16 * 64); \
  }
#define G_READ_B(OFF, FB)                                                                          \
  {                                                                                                \
    const unsigned char* pb_ = smem + (OFF) + rdB_off;                                             \
    _Pragma("unroll") for (int nt = 0; nt < 4; ++nt) FB[nt] = *(const bf16x8*)(pb_ + nt * 16 * 64); \
  }
#define G_READ_HI(OFF, FAH)                                                                        \
  {                                                                                                \
    const unsigned char* pa_ = smem + (OFF) + rdA_off + 64 * 64;                                   \
    _Pragma("unroll") for (int mt = 0; mt < 4; ++mt) FAH[mt] = *(const bf16x8*)(pa_ + mt * 16 * 64); \
  }
#define G_MMA_H(H, FA, FB)                                                                         \
  {                                                                                                \
    _Pragma("unroll") for (int mt = 0; mt < 4; ++mt)                                               \
      _Pragma("unroll") for (int nt = 0; nt < 4; ++nt)                                             \
        acc[(H) * 4 + mt][nt] = __builtin_amdgcn_mfma_f32_16x16x32_bf16(FB[nt], FA[mt], acc[(H) * 4 + mt][nt], 0, 0, 0); \
  }
#define SB __builtin_amdgcn_sched_barrier(0)
#define WAIT_BAR(N) asm volatile("s_waitcnt vmcnt(" #N ")\n\ts_barrier" ::: "memory")
#define STAGE_B 32768

template <class AF>
__device__ __forceinline__ void gemm_tile(unsigned char* smem, const AF& af, const bf16_t* __restrict__ W, int ldw,
                                          int nk, int m0, int n0, int mmax, f32x4 (&acc)[8][4]) {
  const int tid = threadIdx.x, lane = tid & 63, wave = tid >> 6;
  const int wm = wave >> 2, wn = wave & 3;
  const int r = lane & 15, q = lane >> 4;
  const int ns = nk * 2;
#pragma unroll
  for (int i = 0; i < 8; ++i)
#pragma unroll
    for (int j = 0; j < 4; ++j) acc[i][j] = (f32x4){0.f, 0.f, 0.f, 0.f};
  const int dchunk = (lane & 3) ^ ((4 - ((lane >> 4) & 3)) & 3);
  const int rpos = (q ^ ((4 - ((r >> 2) & 3)) & 3)) << 4;
  const int rdA_off = (wm * 128 + r) * 64 + rpos;
  const int rdB_off = 16384 + (wn * 64 + r) * 64 + rpos;
  bf16x8 fb[4], falA[4], falB[4], fah[4];
  G_DMA(0, 0);
  G_DMA(1, STAGE_B);
  G_DMA(2, 2 * STAGE_B);
  WAIT_BAR(4);
  G_READ_B(0, fb);
  G_READ_LO(0, falA);
  int o0 = 0, o1 = STAGE_B, o2 = 2 * STAGE_B, o3 = 3 * STAGE_B;
#define MID_BAR asm volatile("s_waitcnt lgkmcnt(0)\n\ts_barrier" ::: "memory")
  if (wm == 1) __builtin_amdgcn_s_barrier();
#pragma unroll 1
  for (int t = 0; t < ns; t += 2) {
    G_DMA(t + 3, o3);
    SB;
    G_READ_HI(o0, fah);
    G_MMA_H(0, falA, fb);
    SB;
    MID_BAR;
    G_READ_LO(o1, falB);
    G_MMA_H(1, fah, fb);
    SB;
    G_READ_B(o1, fb);
    WAIT_BAR(4);
    { int tmp = o0; o0 = o1; o1 = o2; o2 = o3; o3 = tmp; }
    G_DMA(t + 4, o3);
    SB;
    G_READ_HI(o0, fah);
    G_MMA_H(0, falB, fb);
    SB;
    MID_BAR;
    G_READ_LO(o1, falA);
    G_MMA_H(1, fah, fb);
    SB;
    G_READ_B(o1, fb);
    WAIT_BAR(4);
    { int tmp = o0; o0 = o1; o1 = o2; o2 = o3; o3 = tmp; }
  }
  if (wm == 0) __builtin_amdgcn_s_barrier();
  asm volatile("s_waitcnt vmcnt(0) lgkmcnt(0)\n\ts_barrier" ::: "memory");
}

__device__ __forceinline__ void wconv_item(const float* __restrict__ src, int N, bf16_t* __restrict__ dst, int kb, int n,
                                           int glu, const float* ks1, const float* ks2) {
  float v[32];
  const float* sp = src + (size_t)(kb * 32) * N + n;
#pragma unroll
  for (int i = 0; i < 32; ++i) v[i] = sp[(size_t)i * N];
  if (ks1) {
#pragma unroll
    for (int i = 0; i < 32; ++i) { int k = kb * 32 + i; v[i] *= (k < 512) ? ks1[k] : ks2[k - 512]; }
  }
  int nd = n;
  if (glu) { int sgl = n >> 9, f = n & 511; nd = 64 * (f >> 5) + 32 * sgl + (f & 31); }
  uint4* dp = (uint4*)(dst + ((size_t)kb * N + nd) * 32);
#pragma unroll
  for (int c = 0; c < 4; ++c) {
    uint4 o;
    o.x = pack2(v[c * 8 + 0], v[c * 8 + 1]); o.y = pack2(v[c * 8 + 2], v[c * 8 + 3]);
    o.z = pack2(v[c * 8 + 4], v[c * 8 + 5]); o.w = pack2(v[c * 8 + 6], v[c * 8 + 7]);
    dp[c] = o;
  }
}

__device__ void job_mod(float* lds, const Params& P, int j) {
  const int tid = threadIdx.x;
  float* sc = lds; float* red = lds + 9216;
  const float* c = P.in[1]; const float* cctx = P.in[3];
  const float* aw = P.in[4]; const float* ab = P.in[5];
  float* mod = (float*)(P.ws + OFF_MOD);
  for (int e = tid; e < 9216; e += NT) {
    int rr = e >> 10, k = e & 1023;
    float v = rr < 8 ? c[rr * 1024 + k] : cctx[k];
    sc[e] = v / (1.0f + __expf(-v));
  }
  __syncthreads();
  const int n0 = j * 64, col = tid & 63, kg = tid >> 6;
  float acc[9];
#pragma unroll
  for (int i = 0; i < 9; ++i) acc[i] = 0.f;
#pragma unroll 16
  for (int k = kg * 128; k < kg * 128 + 128; ++k) {
    float w = aw[(size_t)k * 6144 + n0 + col];
#pragma unroll
    for (int i = 0; i < 9; ++i) acc[i] += sc[i * 1024 + k] * w;
  }
#pragma unroll
  for (int i = 0; i < 9; ++i) red[(kg * 9 + i) * 64 + col] = acc[i];
  __syncthreads();
  for (int e = tid; e < 576; e += NT) {
    int rr = e >> 6, cc = e & 63;
    float s = ab[n0 + cc];
#pragma unroll
    for (int g = 0; g < 8; ++g) s += red[(g * 9 + rr) * 64 + cc];
    mod[rr * 6144 + n0 + cc] = s;
  }
  __syncthreads();
}

__device__ void job_pos(const Params& P) {
  float* E = (float*)(P.ws + OFF_POS);
  for (int e = threadIdx.x; e < 64 * 512; e += NT) {
    int p = e >> 9, d = e & 511, i = d & 255;
    float omega = exp2f(-(float)i * (13.287712379549449f / 256.0f));
    float ang = (float)p * omega;
    E[e] = d < 256 ? hsin(ang) : hcos(ang);
  }
}

__device__ void job_s5mats(float* lds, const Params& P, int g, int sj) {
  const int tid = threadIdx.x;
  float2* pw = (float2*)lds;
  float2* bb = pw + 2 * 17 * 64;
  float2* cc = bb + 2 * 64 * 16;
  float* KK = (float*)(cc + 2 * 16 * 64);
  const float* a_re = P.in[8]; const float* a_im = P.in[9]; const float* lstep = P.in[10];
  const float* b_re = P.in[11]; const float* b_im = P.in[12];
  const float* c_re = P.in[13]; const float* c_im = P.in[14];
  const float* dsk = P.in[15];
  bf16_t* Win = (bf16_t*)(P.ws + OFF_S5WIN) + (size_t)g * 65536;
  bf16_t* Wcat = (bf16_t*)(P.ws + OFF_S5WCAT) + (size_t)g * 131072;
  for (int e = tid; e < 2 * 17 * 64; e += NT) {
    int d = e / 1088, rem = e % 1088, tau = rem >> 6, p = rem & 63;
    float are = a_re[(d * 32 + g) * 64 + p], aim = a_im[(d * 32 + g) * 64 + p];
    float step = __expf(lstep[d * 32 + g]);
    float mag = __expf(are * step * (float)tau);
    float ang = aim * step * (float)tau;
    pw[e] = make_float2(mag * hcos(ang), mag * hsin(ang));
  }
  for (int e = tid; e < 2 * 64 * 16; e += NT) {
    int d = e >> 10, p = (e >> 4) & 63, ch = e & 15;
    float are = a_re[(d * 32 + g) * 64 + p], aim = a_im[(d * 32 + g) * 64 + p];
    float step = __expf(lstep[d * 32 + g]);
    float mag = __expf(are * step);
    float ang = aim * step;
    float nr = mag * hcos(ang) - 1.0f, ni = mag * hsin(ang);
    float den = 1.0f / (are * are + aim * aim);
    float qr = (nr * are + ni * aim) * den, qi = (ni * are - nr * aim) * den;
    size_t bi = ((size_t)((d * 32 + g) * 64 + p)) * 16 + ch;
    float br = b_re[bi], bim = b_im[bi];
    bb[e] = make_float2(qr * br - qi * bim, qr * bim + qi * br);
  }
  for (int e = tid; e < 2 * 16 * 64; e += NT) {
    int d = e >> 10, ch = (e >> 6) & 15, p = e & 63;
    size_t ci = ((size_t)((d * 32 + g) * 16 + ch)) * 64 + p;
    cc[e] = make_float2(c_re[ci], c_im[ci]);
  }
  __syncthreads();
  for (int e0 = tid; e0 < 2048; e0 += NT) {
    int d = e0 >> 10, tau = sj * 4 + ((e0 >> 8) & 3), ch = (e0 >> 4) & 15, ch2 = e0 & 15;
    int e = (d << 12) | (tau << 8) | (ch << 4) | ch2;
    float s = 0.f;
    for (int p = 0; p < 64; ++p) {
      float2 c = cc[(d * 16 + ch) * 64 + p], w = pw[(d * 17 + tau) * 64 + p], b = bb[(d * 64 + p) * 16 + ch2];
      float cr = c.x * w.x - c.y * w.y, ci = c.x * w.y + c.y * w.x;
      s += cr * b.x - ci * b.y;
    }
    KK[e] = s;
  }
  for (int e = tid * 4 + sj; e < 8192; e += NT * 4) {
    int n = e >> 5, k8 = (e & 31) * 8;
    int d = n >> 7, p = (n & 127) >> 1, ri = n & 1;
    int i = k8 >> 4, ch0 = k8 & 15;
    int tau = d == 0 ? 15 - i : i;
    float2 w = pw[(d * 17 + tau) * 64 + p];
    float v[8];
#pragma unroll
    for (int t = 0; t < 8; ++t) {
      float2 b = bb[(d * 64 + p) * 16 + ch0 + t];
      v[t] = ri ? (w.x * b.y + w.y * b.x) : (w.x * b.x - w.y * b.y);
    }
    uint4 o; o.x = pack2(v[0], v[1]); o.y = pack2(v[2], v[3]); o.z = pack2(v[4], v[5]); o.w = pack2(v[6], v[7]);
    *(uint4*)(Win + ((size_t)(k8 >> 5) * 256 + n) * 32 + (k8 & 31)) = o;
  }
  for (int e = tid * 4 + sj; e < 8192; e += NT * 4) {
    int n = e >> 5, k8 = (e & 31) * 8;
    int j = n >> 4, ch = n & 15;
    float v[8];
#pragma unroll
    for (int t = 0; t < 8; ++t) {
      int kk = k8 + t;
      int d = kk >> 7, p = (kk & 127) >> 1, ri = kk & 1;
      int tau = d == 0 ? j + 1 : 16 - j;
      float2 c = cc[(d * 16 + ch) * 64 + p], w = pw[(d * 17 + tau) * 64 + p];
      v[t] = ri ? -(c.x * w.y + c.y * w.x) : (c.x * w.x - c.y * w.y);
    }
    uint4 o; o.x = pack2(v[0], v[1]); o.y = pack2(v[2], v[3]); o.z = pack2(v[4], v[5]); o.w = pack2(v[6], v[7]);
    *(uint4*)(Wcat + ((size_t)((256 + k8) >> 5) * 256 + n) * 32 + (k8 & 31)) = o;
  }
  __syncthreads();
  for (int e = tid; e < 8192; e += NT) {
    int n = e >> 5, k8 = (e & 31) * 8;
    int j = n >> 4, ch = n & 15;
    int i = k8 >> 4, ch0 = k8 & 15;
    if (((i > j ? i - j : j - i) >> 2) != sj) continue;
    float v[8];
#pragma unroll
    for (int t = 0; t < 8; ++t) {
      int ch2 = ch0 + t;
      float s = 0.f;
      if (i <= j) s += KK[((0 * 16 + (j - i)) * 16 + ch) * 16 + ch2];
      if (i >= j) s += KK[((1 * 16 + (i - j)) * 16 + ch) * 16 + ch2];
      if (i == j && ch == ch2) s += dsk[g * 16 + ch];
      v[t] = s;
    }
    uint4 o; o.x = pack2(v[0], v[1]); o.y = pack2(v[2], v[3]); o.z = pack2(v[4], v[5]); o.w = pack2(v[6], v[7]);
    *(uint4*)(Wcat + ((size_t)(k8 >> 5) * 256 + n) * 32 + (k8 & 31)) = o;
  }
  __syncthreads();
}

__device__ void job_filter(float* lds, const Params& P, int it) {
  const int tid = threadIdx.x;
  float* emb = lds;
  float* h1 = lds + 528;
  float* h2s = lds + 528 + 1024;
  const float* w1 = P.in[20]; const float* b1 = P.in[21]; const float* w2 = P.in[22]; const float* b2 = P.in[23];
  const float* fr = P.in[24]; const float* w3 = P.in[25]; const float* decay = P.in[26];
  float* filt = (float*)(P.ws + OFF_FILT);
  const int t0 = it * 16;
  for (int e = tid; e < 16 * 33; e += NT) {
    int tt = e / 33, qq = e % 33;
    int t = t0 + tt;
    float val;
    if (qq == 0) val = (float)t / 4095.0f;
    else {
      int k = (qq - 1) & 15;
      float band = 1e-4f + (float)k * ((15.0f - 1e-4f) / 15.0f);
      float rev = (float)t * band * (1.0f / 4096.0f);
      val = qq <= 16 ? cosrev(rev) : -sinrev(rev);
    }
    emb[e] = val;
  }
  __syncthreads();
  for (int e = tid; e < 1024; e += NT) {
    int tt = e >> 6, m = e & 63;
    float s = b1[m];
#pragma unroll 11
    for (int qq = 0; qq < 33; ++qq) s += emb[tt * 33 + qq] * w1[qq * 64 + m];
    h1[e] = hsin(fr[m] * s);
  }
  __syncthreads();
  for (int e = tid; e < 1024; e += NT) {
    int tt = e >> 6, m = e & 63;
    float s = b2[m];
#pragma unroll 16
    for (int qq = 0; qq < 64; ++qq) s += h1[tt * 64 + qq] * w2[qq * 64 + m];
    h2s[m * 16 + tt] = hsin(fr[m] * s);
  }
  __syncthreads();
  {
    float acc[4][16];
#pragma unroll
    for (int cq = 0; cq < 4; ++cq)
#pragma unroll
      for (int i = 0; i < 16; ++i) acc[cq][i] = 0.f;
#pragma unroll 4
    for (int m = 0; m < 64; ++m) {
      float w[4];
#pragma unroll
      for (int cq = 0; cq < 4; ++cq) w[cq] = w3[m * 2048 + tid + 512 * cq];
      const float4* hp = (const float4*)(h2s + m * 16);
#pragma unroll
      for (int i = 0; i < 4; ++i) {
        float4 h = hp[i];
#pragma unroll
        for (int cq = 0; cq < 4; ++cq) {
          acc[cq][i * 4 + 0] += h.x * w[cq]; acc[cq][i * 4 + 1] += h.y * w[cq];
          acc[cq][i * 4 + 2] += h.z * w[cq]; acc[cq][i * 4 + 3] += h.w * w[cq];
        }
      }
    }
#pragma unroll
    for (int cq = 0; cq < 4; ++cq) {
      int col = tid + 512 * cq;
      int order = col >> 10, dir = (col >> 9) & 1, c = col & 511;
      float dec = fabsf(decay[order * 512 + c]);
      float* dst = filt + ((size_t)((order * 2 + dir) * 512 + c)) * 4096 + t0;
#pragma unroll
      for (int i = 0; i < 4; ++i) {
        float4 o;
        o.x = acc[cq][i * 4 + 0] * __expf(-((float)(t0 + i * 4 + 0) / 4095.0f) * dec);
        o.y = acc[cq][i * 4 + 1] * __expf(-((float)(t0 + i * 4 + 1) / 4095.0f) * dec);
        o.z = acc[cq][i * 4 + 2] * __expf(-((float)(t0 + i * 4 + 2) / 4095.0f) * dec);
        o.w = acc[cq][i * 4 + 3] * __expf(-((float)(t0 + i * 4 + 3) / 4095.0f) * dec);
        *(float4*)(dst + i * 4) = o;
      }
    }
  }
  __syncthreads();
}

__device__ void phase0(unsigned char* smem, const Params& P) {
  float* lds = (float*)smem;
  const int G = gridDim.x;
  {
    const int nthreads = G * NT;
#pragma unroll 1
    for (int it = blockIdx.x * NT + threadIdx.x; it < 376832; it += nthreads) {
      int u = it;
      if (u < 65536) wconv_item(P.in[7], 2048, (bf16_t*)(P.ws + OFF_WTIN), u >> 11, u & 2047, 0, nullptr, nullptr);
      else if ((u -= 65536) < 16384) wconv_item(P.in[16], 1024, (bf16_t*)(P.ws + OFF_WTGLU), u >> 10, u & 1023, 1, nullptr, nullptr);
      else if ((u -= 16384) < 32768) wconv_item(P.in[30], 1024, (bf16_t*)(P.ws + OFF_WTOUT), u >> 10, u & 1023, 0, P.in[28], P.in[29]);
      else if ((u -= 32768) < 131072) wconv_item(P.in[32], 4096, (bf16_t*)(P.ws + OFF_WT1), u >> 12, u & 4095, 0, nullptr, nullptr);
      else { u -= 131072; wconv_item(P.in[33], 1024, (bf16_t*)(P.ws + OFF_WT2), u >> 10, u & 1023, 0, nullptr, nullptr); }
    }
  }
#pragma unroll 1
  for (int w = blockIdx.x; w < 256; w += G) job_filter(lds, P, w);
#pragma unroll 1
  for (int w = (blockIdx.x + 128) % G; w < 128; w += G) job_s5mats(lds, P, w >> 2, w & 3);
#pragma unroll 1
  for (int w = blockIdx.x; w < 96; w += G) job_mod(lds, P, w);
  if (blockIdx.x == 100) job_pos(P);
}

#define NRF 4
__device__ __forceinline__ void phase_rownorm(const Params& P, int mode) {
  const int lane = threadIdx.x & 63, wave = threadIdx.x >> 6;
  const float* mod = (const float*)(P.ws + OFF_MOD);
  const float* E = (const float*)(P.ws + OFF_POS);
  bf16_t* A1 = (bf16_t*)(P.ws + OFF_A1);
  const bool first = (mode == 0 || mode == 3);
  const int nrows = mode == 3 ? 34816 : 32768;
  const float* gain = first ? P.in[6] : (mode == 1 ? P.in[31] : P.in[34]);
  const int sh_off = first ? 0 : 3072, sc_off = first ? 1024 : 4096;
  const int nblk = mode == 0 ? (int)gridDim.x - 16 : (int)gridDim.x;
  const int bid = mode == 0 ? (int)blockIdx.x - 16 : (int)blockIdx.x;
  const int stride = nblk * 8;
  const int rbeg = mode == 3 ? 32768 : 0;
#pragma unroll 1
  for (int row0 = rbeg + bid * 8 + wave; row0 < nrows; row0 += NRF * stride) {
    float4 v[NRF][4];
    float ss[NRF];
    int bsel[NRF];
#pragma unroll
    for (int j = 0; j < NRF; ++j) {
      int row = min(row0 + j * stride, nrows - 1);
      const float* src;
      if (first) {
        if (row < 32768) { src = P.in[0] + (size_t)row * 1024; bsel[j] = row >> 12; }
        else { src = P.in[2] + (size_t)(row - 32768) * 1024; bsel[j] = 8; }
      } else { src = P.out + (size_t)row * 1024; bsel[j] = row >> 12; }
#pragma unroll
      for (int i = 0; i < 4; ++i) v[j][i] = *(const float4*)(src + lane * 4 + 256 * i);
    }
#pragma unroll
    for (int j = 0; j < NRF; ++j) {
      int row = min(row0 + j * stride, nrows - 1);
      float s = 0.f;
#pragma unroll
      for (int i = 0; i < 4; ++i) {
        int d = lane * 4 + 256 * i;
        if (first && row < 32768) {
          int l = row & 4095;
          float4 e = (i < 2) ? *(const float4*)(E + (l >> 6) * 512 + d) : *(const float4*)(E + (l & 63) * 512 + d - 512);
          v[j][i].x += e.x; v[j][i].y += e.y; v[j][i].z += e.z; v[j][i].w += e.w;
        }
        s += v[j][i].x * v[j][i].x + v[j][i].y * v[j][i].y + v[j][i].z * v[j][i].z + v[j][i].w * v[j][i].w;
      }
      ss[j] = s;
    }
#pragma unroll
    for (int j = 0; j < NRF; ++j) ss[j] = wave_sum(ss[j]);
#pragma unroll
    for (int j = 0; j < NRF; ++j) {
      int row = row0 + j * stride;
      if (row >= nrows) continue;
      const int b = bsel[j];
      float rinv = rsqrtf(ss[j] * (1.0f / 1024.0f) + 1e-6f);
#pragma unroll
      for (int i = 0; i < 4; ++i) {
        int d = lane * 4 + 256 * i;
        float4 g = *(const float4*)(gain + d);
        float4 o;
        o.x = v[j][i].x * rinv * g.x; o.y = v[j][i].y * rinv * g.y; o.z = v[j][i].z * rinv * g.z; o.w = v[j][i].w * rinv * g.w;
        if (mode == 2) {
          *(float4*)(P.out + (size_t)row * 1024 + d) = o;
        } else {
          float4 sc = *(const float4*)(mod + b * 6144 + sc_off + d);
          float4 sh = *(const float4*)(mod + b * 6144 + sh_off + d);
          o.x = o.x * (1.0f + sc.x) + sh.x; o.y = o.y * (1.0f + sc.y) + sh.y;
          o.z = o.z * (1.0f + sc.z) + sh.z; o.w = o.w * (1.0f + sc.w) + sh.w;
          uint2 pk; pk.x = pack2(o.x, o.y); pk.y = pack2(o.z, o.w);
          *(uint2*)(A1 + ((size_t)(d >> 5) * 34816 + row) * 32 + (d & 31)) = pk;
        }
      }
    }
  }
}

__device__ __forceinline__ void tile_map(int t, int lg, int& tm, int& tn) {
  if (gridDim.x != 256) { tm = t >> lg; tn = t & ((1 << lg) - 1); return; }
  const int round = t >> 8, bid = t & 255, x = bid & 7, j = bid >> 3;
  if (lg == 2) { tm = round * 64 + x * 8 + (j >> 2); tn = j & 3; }
  else if (lg == 3) { tm = round * 32 + x * 4 + (j >> 3); tn = j & 7; }
  else { tm = round * 16 + (x >> 1) * 4 + (j >> 3); tn = (x & 1) * 8 + (j & 7); }
}

__device__ __forceinline__ void phase_gemm1(unsigned char* smem, const Params& P, int ctx_only) {
  const int lane = threadIdx.x & 63, wave = threadIdx.x >> 6, wm = wave >> 2, wn = wave & 3, r = lane & 15, q = lane >> 4;
  ABlk af{(const bf16_t*)(P.ws + OFF_A1), 34816};
  const bf16_t* W = (const bf16_t*)(P.ws + OFF_WTIN);
  bf16_t* A2 = (bf16_t*)(P.ws + OFF_A2);
  bf16_t* Z = (bf16_t*)(P.ws + OFF_Z);
  unsigned char* stg = smem + wave * 9216;
  for (int t = ctx_only ? 1024 + (int)blockIdx.x : (int)blockIdx.x; t < (ctx_only ? 1040 : 1024); t += gridDim.x) {
    int tm, tn;
    if (t < 1024) tile_map(t, 3, tm, tn); else { tm = 128 + ((t - 1024) >> 1); tn = t & 1; }
    f32x4 acc[8][4];
    gemm_tile(smem, af, W, 2048, 16, tm * 256, tn * 256, 34816, acc);
    if (tn < 2) {
#pragma unroll
      for (int half = 0; half < 2; ++half) {
#pragma unroll
        for (int mt = 0; mt < 4; ++mt) {
#pragma unroll
          for (int nt = 0; nt < 4; ++nt) {
            f32x4 a = acc[half * 4 + mt][nt];
            uint2 pk; pk.x = pack2(a[0], a[1]); pk.y = pack2(a[2], a[3]);
            *(uint2*)(stg + ((mt * 4 + nt) * 16 + r) * 32 + q * 8) = pk;
          }
        }
        __builtin_amdgcn_sched_barrier(0);
        const int mbase = tm * 256 + wm * 128 + half * 64;
        int rowbase;
        if (mbase < 32768) rowbase = (mbase >> 12) * 256 + ((mbase & 4095) >> 4);
        else { int mc = mbase - 32768; rowbase = 2048 + (mc >> 8) * 16 + ((mc & 255) >> 4); }
        const int g0 = (tn * 256 + wn * 64) >> 4;
#pragma unroll
        for (int i = 0; i < 8; ++i) {
          const int blk = i * 2 + (lane >> 5);
          const int mt = blk >> 2, nt = blk & 3;
          uint4 v = *(const uint4*)(stg + blk * 512 + (lane & 31) * 16);
          *(uint4*)(A2 + (size_t)(g0 + nt) * 2176 * 512 + ((size_t)((lane & 31) >> 2) * 2176 + rowbase + mt) * 32 + (lane & 3) * 8) = v;
        }
        __builtin_amdgcn_sched_barrier(0);
      }
    } else {
      const int cz0 = tn * 256 + wn * 64 - 512;
#pragma unroll
      for (int half = 0; half < 2; ++half) {
#pragma unroll
        for (int mt = 0; mt < 4; ++mt) {
#pragma unroll
          for (int nt = 0; nt < 4; ++nt) {
            f32x4 a = acc[half * 4 + mt][nt];
#pragma unroll
            for (int jj = 0; jj < 4; ++jj)
              *(bf16_t*)(stg + (nt * 16 + 4 * q + jj) * 144 + (mt * 16 + r) * 2) = f2bf(a[jj]);
          }
        }
        __builtin_amdgcn_sched_barrier(0);
        const int mbase = tm * 256 + wm * 128 + half * 64;
        const int b = mbase >> 12, l0 = mbase & 4095;
#pragma unroll
        for (int i = 0; i < 8; ++i) {
          int row = i * 8 + (lane >> 3), chunk = lane & 7;
          uint4 v = *(const uint4*)(stg + row * 144 + chunk * 16);
          *(uint4*)(Z + ((size_t)((cz0 + row) * 8 + b)) * 4096 + l0 + chunk * 8) = v;
        }
        __builtin_amdgcn_sched_barrier(0);
      }
    }
    __syncthreads();
  }
}

__device__ void phase_s5g1(unsigned char* smem, const Params& P) {
  const int lane = threadIdx.x & 63, wave = threadIdx.x >> 6, wm = wave >> 2, wn = wave & 3, r = lane & 15, q = lane >> 4;
  float* Sloc = (float*)(P.ws + OFF_SLOC);
  for (int t = blockIdx.x; t < 288; t += gridDim.x) {
    int g = t / 9, tm = t % 9, tn = 0;
    ABlk af{(const bf16_t*)(P.ws + OFF_A2) + (size_t)g * 2176 * 512, 2176};
    const bf16_t* W = (const bf16_t*)(P.ws + OFF_S5WIN) + (size_t)g * 65536;
    f32x4 acc[8][4];
    gemm_tile(smem, af, W, 256, 4, tm * 256, tn * 256, 2176, acc);
#pragma unroll
    for (int mt = 0; mt < 8; ++mt) {
      int m = tm * 256 + wm * 128 + mt * 16 + r;
      if (m < 2176) {
#pragma unroll
        for (int nt = 0; nt < 4; ++nt) {
          int n = tn * 256 + wn * 64 + nt * 16 + 4 * q;
          f32x4 a = acc[mt][nt];
          *(float4*)(Sloc + ((size_t)(g * 2176 + m)) * 256 + n) = make_float4(a[0], a[1], a[2], a[3]);
        }
      }
    }
  }
}

__device__ void phase_s5scan(const Params& P) {
  const float* a_re = P.in[8]; const float* a_im = P.in[9]; const float* lstep = P.in[10];
  if (threadIdx.x >= 128) return;
  for (int idx = blockIdx.x * 128 + threadIdx.x; idx < 32768; idx += gridDim.x * 128) {
    int p = idx & 63, b = (idx >> 6) & 7, d = (idx >> 9) & 1, g = idx >> 10;
    float are = a_re[(d * 32 + g) * 64 + p], aim = a_im[(d * 32 + g) * 64 + p];
    float step = __expf(lstep[d * 32 + g]);
    float mag = __expf(are * step * 16.0f), ang = aim * step * 16.0f;
    float lr_ = mag * hcos(ang), li_ = mag * hsin(ang);
    const float* sl = (const float*)(P.ws + OFF_SLOC) + (size_t)g * 2176 * 256 + d * 128 + 2 * p;
    bf16_t* dst = (bf16_t*)(P.ws + OFF_A2) + (size_t)g * 2176 * 512 + (size_t)(8 + d * 4 + (p >> 4)) * 2176 * 32 + 2 * (p & 15);
    float sr = 0.f, si = 0.f;
    float2 xs[16];
#pragma unroll
    for (int cc = 0; cc < 16; ++cc) {
      int ci = d == 0 ? cc : 15 - cc;
      xs[cc] = *(const float2*)(sl + (size_t)(2048 + b * 16 + ci) * 256);
    }
#pragma unroll
    for (int cc = 0; cc < 16; ++cc) {
      float nr = lr_ * sr - li_ * si + xs[cc].x, ni = lr_ * si + li_ * sr + xs[cc].y;
      sr = nr; si = ni;
    }
#pragma unroll 1
    for (int c0 = 0; c0 < 256; c0 += 16) {
#pragma unroll
      for (int cc = 0; cc < 16; ++cc) {
        int c = c0 + cc;
        int ci = d == 0 ? c : 255 - c;
        xs[cc] = *(const float2*)(sl + (size_t)(b * 256 + ci) * 256);
      }
#pragma unroll
      for (int cc = 0; cc < 16; ++cc) {
        int c = c0 + cc;
        int ci = d == 0 ? c : 255 - c;
        *(unsigned*)(dst + (size_t)(b * 256 + ci) * 32) = pack2(sr, si);
        float nr = lr_ * sr - li_ * si + xs[cc].x, ni = lr_ * si + li_ * sr + xs[cc].y;
        sr = nr; si = ni;
      }
    }
  }
}

__device__ void phase_s5g2(unsigned char* smem, const Params& P) {
  const int lane = threadIdx.x & 63, wave = threadIdx.x >> 6, wm = wave >> 2, wn = wave & 3, r = lane & 15, q = lane >> 4;
  bf16_t* Y = (bf16_t*)(P.ws + OFF_YS5G);
  for (int t = blockIdx.x; t < 256; t += gridDim.x) {
    int g = t >> 3, tm = t & 7, tn = 0;
    ABlk af{(const bf16_t*)(P.ws + OFF_A2) + (size_t)g * 2176 * 512, 2176};
    const bf16_t* W = (const bf16_t*)(P.ws + OFF_S5WCAT) + (size_t)g * 131072;
    f32x4 acc[8][4];
    gemm_tile(smem, af, W, 256, 8, tm * 256, tn * 256, 2048, acc);
#pragma unroll
    for (int mt = 0; mt < 8; ++mt) {
      int m = tm * 256 + wm * 128 + mt * 16 + r;
#pragma unroll
      for (int nt = 0; nt < 4; ++nt) {
        int n = tn * 256 + wn * 64 + nt * 16 + 4 * q;
        f32x4 a = acc[mt][nt];
        uint2 pk; pk.x = pack2(gelu_tanh(a[0]), gelu_tanh(a[1])); pk.y = pack2(gelu_tanh(a[2]), gelu_tanh(a[3]));
        {
          const int token = m * 16 + (n >> 4), ch = n & 15;
          *(uint2*)(Y + ((size_t)(g >> 1) * 32768 + token) * 32 + (g & 1) * 16 + ch) = pk;
        }
      }
    }
  }
}

__device__ void phase_glu(unsigned char* smem, const Params& P) {
  const int lane = threadIdx.x & 63, wave = threadIdx.x >> 6, wm = wave >> 2, wn = wave & 3, r = lane & 15, q = lane >> 4;
  ABlk af{(const bf16_t*)(P.ws + OFF_YS5G), 32768};
  const bf16_t* W = (const bf16_t*)(P.ws + OFF_WTGLU);
  const float* bias = P.in[17];
  bf16_t* Y = (bf16_t*)(P.ws + OFF_YS5);
  for (int t = blockIdx.x; t < 512; t += gridDim.x) {
    int tm, tn; tile_map(t, 2, tm, tn);
    f32x4 acc[8][4];
    gemm_tile(smem, af, W, 1024, 8, tm * 256, tn * 256, 32768, acc);
    const int qq = (tn * 256 + wn * 64) >> 6;
#pragma unroll
    for (int mt = 0; mt < 8; ++mt) {
      int m = tm * 256 + wm * 128 + mt * 16 + r;
#pragma unroll
      for (int nt = 0; nt < 2; ++nt) {
        int f = 32 * qq + 16 * nt + 4 * q;
        float4 bv = *(const float4*)(bias + f), bg = *(const float4*)(bias + 512 + f);
        f32x4 va = acc[mt][nt], ga = acc[mt][nt + 2];
        float y0 = (va[0] + bv.x) / (1.0f + __expf(-(ga[0] + bg.x)));
        float y1 = (va[1] + bv.y) / (1.0f + __expf(-(ga[1] + bg.y)));
        float y2 = (va[2] + bv.z) / (1.0f + __expf(-(ga[2] + bg.z)));
        float y3 = (va[3] + bv.w) / (1.0f + __expf(-(ga[3] + bg.w)));
        uint2 pk; pk.x = pack2(y0, y1); pk.y = pack2(y2, y3);
        *(uint2*)(Y + (size_t)m * 512 + f) = pk;
      }
    }
  }
}

__device__ void phase_wout(unsigned char* smem, const Params& P) {
  const int lane = threadIdx.x & 63, wave = threadIdx.x >> 6, wm = wave >> 2, wn = wave & 3, r = lane & 15, q = lane >> 4;
  ABlk af{(const bf16_t*)(P.ws + OFF_A1), 34816};
  const bf16_t* W = (const bf16_t*)(P.ws + OFF_WTOUT);
  const float* mod = (const float*)(P.ws + OFF_MOD);
  const float* E = (const float*)(P.ws + OFF_POS);
  const float* x = P.in[0];
  for (int t = blockIdx.x; t < 512; t += gridDim.x) {
    int tm, tn; tile_map(t, 2, tm, tn);
    f32x4 acc[8][4];
    gemm_tile(smem, af, W, 1024, 16, tm * 256, tn * 256, 32768, acc);
    const int b = (tm * 256) >> 12;
    const int nb = tn * 256 + wn * 64 + 4 * q;
#pragma unroll
    for (int mt = 0; mt < 8; ++mt) {
      const int m = tm * 256 + wm * 128 + mt * 16 + r;
      const int l = m & 4095;
      float4 xv[4], ev[4];
#pragma unroll
      for (int nt = 0; nt < 4; ++nt) {
        int n = nb + nt * 16;
        xv[nt] = *(const float4*)(x + (size_t)m * 1024 + n);
        ev[nt] = n < 512 ? *(const float4*)(E + (l >> 6) * 512 + n) : *(const float4*)(E + (l & 63) * 512 + n - 512);
      }
      __builtin_amdgcn_sched_barrier(0);
#pragma unroll
      for (int nt = 0; nt < 4; ++nt) {
        int n = nb + nt * 16;
        f32x4 a = acc[mt][nt];
        float4 gt = *(const float4*)(mod + b * 6144 + 2048 + n);
        float4 o;
        o.x = xv[nt].x + ev[nt].x + gt.x * a[0]; o.y = xv[nt].y + ev[nt].y + gt.y * a[1];
        o.z = xv[nt].z + ev[nt].z + gt.z * a[2]; o.w = xv[nt].w + ev[nt].w + gt.w * a[3];
        *(float4*)(P.out + (size_t)m * 1024 + n) = o;
      }
      __builtin_amdgcn_sched_barrier(0);
    }
  }
}

__device__ void phase_mlp1(unsigned char* smem, const Params& P) {
  const int lane = threadIdx.x & 63, wave = threadIdx.x >> 6, wm = wave >> 2, wn = wave & 3, r = lane & 15, q = lane >> 4;
  ABlk af{(const bf16_t*)(P.ws + OFF_A1), 34816};
  const bf16_t* W = (const bf16_t*)(P.ws + OFF_WT1);
  bf16_t* hid = (bf16_t*)(P.ws + OFF_HID);
  unsigned char* stg = smem + wave * 9216;
  for (int t = blockIdx.x; t < 2048; t += gridDim.x) {
    int tm, tn; tile_map(t, 4, tm, tn);
    f32x4 acc[8][4];
    gemm_tile(smem, af, W, 4096, 16, tm * 256, tn * 256, 32768, acc);
#pragma unroll
    for (int half = 0; half < 2; ++half) {
#pragma unroll
      for (int mt = 0; mt < 4; ++mt) {
#pragma unroll
        for (int nt = 0; nt < 4; ++nt) {
          f32x4 a = acc[half * 4 + mt][nt];
          float r0 = fmaxf(a[0], 0.f), r1 = fmaxf(a[1], 0.f), r2 = fmaxf(a[2], 0.f), r3 = fmaxf(a[3], 0.f);
          uint2 pk; pk.x = pack2(r0 * r0, r1 * r1); pk.y = pack2(r2 * r2, r3 * r3);
          *(uint2*)(stg + (mt * 16 + r) * 144 + (nt * 16 + 4 * q) * 2) = pk;
        }
      }
      __builtin_amdgcn_sched_barrier(0);
#pragma unroll
      for (int i = 0; i < 8; ++i) {
        int row = i * 8 + (lane >> 3), chunk = lane & 7;
        uint4 v = *(const uint4*)(stg + row * 144 + chunk * 16);
        int m = tm * 256 + wm * 128 + half * 64 + row;
        *(uint4*)(hid + ((size_t)(tn * 8 + wn * 2 + (chunk >> 2)) * 32768 + m) * 32 + (chunk & 3) * 8) = v;
      }
      __builtin_amdgcn_sched_barrier(0);
    }
    __syncthreads();
  }
}

__device__ void phase_mlp2(unsigned char* smem, const Params& P) {
  const int lane = threadIdx.x & 63, wave = threadIdx.x >> 6, wm = wave >> 2, wn = wave & 3, r = lane & 15, q = lane >> 4;
  ABlk af{(const bf16_t*)(P.ws + OFF_HID), 32768};
  const bf16_t* W = (const bf16_t*)(P.ws + OFF_WT2);
  const float* mod = (const float*)(P.ws + OFF_MOD);
  for (int t = blockIdx.x; t < 512; t += gridDim.x) {
    int tm, tn; tile_map(t, 2, tm, tn);
    f32x4 acc[8][4];
    gemm_tile(smem, af, W, 1024, 64, tm * 256, tn * 256, 32768, acc);
    const int b = (tm * 256) >> 12;
    const int nb = tn * 256 + wn * 64 + 4 * q;
    float4 gt[4];
#pragma unroll
    for (int nt = 0; nt < 4; ++nt) gt[nt] = *(const float4*)(mod + b * 6144 + 5120 + nb + nt * 16);
#pragma unroll
    for (int mp = 0; mp < 4; ++mp) {
      float4 o[2][4];
#pragma unroll
      for (int h = 0; h < 2; ++h)
#pragma unroll
        for (int nt = 0; nt < 4; ++nt) {
          int m = tm * 256 + wm * 128 + (mp * 2 + h) * 16 + r;
          o[h][nt] = *(const float4*)(P.out + (size_t)m * 1024 + nb + nt * 16);
        }
      __builtin_amdgcn_sched_barrier(0);
#pragma unroll
      for (int h = 0; h < 2; ++h)
#pragma unroll
        for (int nt = 0; nt < 4; ++nt) {
          int m = tm * 256 + wm * 128 + (mp * 2 + h) * 16 + r;
          f32x4 a = acc[mp * 2 + h][nt];
          float4 v = o[h][nt];
          v.x += gt[nt].x * a[0]; v.y += gt[nt].y * a[1]; v.z += gt[nt].z * a[2]; v.w += gt[nt].w * a[3];
          *(float4*)(P.out + (size_t)m * 1024 + nb + nt * 16) = v;
        }
      __builtin_amdgcn_sched_barrier(0);
    }
  }
}

__device__ void phase_mixnorm(unsigned char* smem, const Params& P) {
  const int tid = threadIdx.x, lane = tid & 63, wave = tid >> 6;
  bf16_t* hyT = (bf16_t*)smem;
  const bf16_t* Z = (const bf16_t*)(P.ws + OFF_Z);
  const bf16_t* Ys5 = (const bf16_t*)(P.ws + OFF_YS5);
  bf16_t* mix = (bf16_t*)(P.ws + OFF_A1);
  for (int tile = blockIdx.x; tile < 512; tile += gridDim.x) {
    int b = tile >> 6, l0 = (tile & 63) * 64;
    {
      const uint4* src = (const uint4*)(Z + ((size_t)(tid * 8 + b)) * 4096 + l0);
      unsigned* drow = (unsigned*)(hyT + tid * 66);
#pragma unroll
      for (int i = 0; i < 8; ++i) {
        uint4 v = src[i];
        drow[i * 4 + 0] = v.x; drow[i * 4 + 1] = v.y; drow[i * 4 + 2] = v.z; drow[i * 4 + 3] = v.w;
      }
    }
    __syncthreads();
#pragma unroll 1
    for (int hh = 0; hh < 2; ++hh) {
      uint4 svp[4];
#pragma unroll
      for (int i = 0; i < 4; ++i) svp[i] = *(const uint4*)(Ys5 + ((size_t)b * 4096 + l0 + wave * 8 + hh * 4 + i) * 512 + lane * 8);
#pragma unroll
      for (int ti = 0; ti < 4; ++ti) {
        const int tt = wave * 8 + hh * 4 + ti;
        size_t token = (size_t)b * 4096 + l0 + tt;
      uint4 sv = svp[ti];
      float s[8];
      s[0] = bf2f(sv.x & 0xffff); s[1] = bf2f(sv.x >> 16); s[2] = bf2f(sv.y & 0xffff); s[3] = bf2f(sv.y >> 16);
      s[4] = bf2f(sv.z & 0xffff); s[5] = bf2f(sv.z >> 16); s[6] = bf2f(sv.w & 0xffff); s[7] = bf2f(sv.w >> 16);
      float h[8];
      float ss5 = 0.f, ssh = 0.f;
#pragma unroll
      for (int i = 0; i < 8; ++i) {
        h[i] = bf2f(hyT[(2 * lane + 128 * (i >> 1) + (i & 1)) * 66 + tt]);
        ss5 += s[i] * s[i]; ssh += h[i] * h[i];
      }
      ss5 = wave_sum(ss5); ssh = wave_sum(ssh);
      float r5 = rsqrtf(ss5 * (1.0f / 512.0f) + 1e-6f), rh = rsqrtf(ssh * (1.0f / 512.0f) + 1e-6f);
      uint4 o;
      o.x = pack2(s[0] * r5, s[1] * r5); o.y = pack2(s[2] * r5, s[3] * r5);
      o.z = pack2(s[4] * r5, s[5] * r5); o.w = pack2(s[6] * r5, s[7] * r5);
      *(uint4*)(mix + ((size_t)(lane >> 2) * 34816 + token) * 32 + (lane & 3) * 8) = o;
#pragma unroll
      for (int i = 0; i < 4; ++i) {
        const int c = 2 * lane + 128 * i;
        *(unsigned*)(mix + ((size_t)(16 + (c >> 5)) * 34816 + token) * 32 + (c & 31)) = pack2(h[2 * i] * rh, h[2 * i + 1] * rh);
      }
          }
    }
    __syncthreads();
  }
}

__device__ __forceinline__ constexpr int SW(int i) { return i ^ ((i >> 3) & 31); }
#define DSW(PTR, TYPE, SWB8, C) (*(TYPE*)((unsigned char*)(PTR) + ((SWB8) ^ (SW(C) << 3))))

typedef float v2f __attribute__((ext_vector_type(2)));
#define C16(k) (C16_TAB[(k) & 15])
#define S16(k) (S16_TAB[(k) & 15])
__device__ constexpr float C16_TAB[16] = {1.000000000e+00f, 9.238795325e-01f, 7.071067812e-01f, 3.826834324e-01f, 6.123233996e-17f, -3.826834324e-01f, -7.071067812e-01f, -9.238795325e-01f, -1.000000000e+00f, -9.238795325e-01f, -7.071067812e-01f, -3.826834324e-01f, -1.836970199e-16f, 3.826834324e-01f, 7.071067812e-01f, 9.238795325e-01f};
__device__ constexpr float S16_TAB[16] = {0.000000000e+00f, 3.826834324e-01f, 7.071067812e-01f, 9.238795325e-01f, 1.000000000e+00f, 9.238795325e-01f, 7.071067812e-01f, 3.826834324e-01f, 1.224646799e-16f, -3.826834324e-01f, -7.071067812e-01f, -9.238795325e-01f, -1.000000000e+00f, -9.238795325e-01f, -7.071067812e-01f, -3.826834324e-01f};

struct TwBase { float c[4], s[4]; };
template <int S0>
__device__ __forceinline__ TwBase make_twbase(int lo) {
  TwBase t;
  float rev = (float)lo * (1.0f / (float)(1 << (13 - S0)));
  t.c[0] = cosrev(rev); t.s[0] = sinrev(rev);
#pragma unroll
  for (int u = 1; u < 4; ++u) { t.c[u] = t.c[u - 1] * t.c[u - 1] - t.s[u - 1] * t.s[u - 1]; t.s[u] = 2.0f * t.c[u - 1] * t.s[u - 1]; }
  return t;
}
template <int NS, int S0, bool INV, bool TOKS = false>
__device__ __forceinline__ void fft_pass(float2* Df, int tid0, float2* KSout = nullptr, const TwBase* twb = nullptr) {
  v2f* D = (v2f*)Df;
  constexpr int R = 1 << NS;
  constexpr int pos = 13 - S0 - NS;
#pragma unroll 1
  for (int tix = tid0; tix < (8192 >> NS); tix += NT) {
    const int lo = tix & ((1 << pos) - 1), hi = tix >> pos;
    const int base = (hi << (pos + NS)) | lo;
    v2f v[R];
    const int swb8 = SW(base) << 3;
#pragma unroll
    for (int e = 0; e < R; ++e) v[e] = DSW(D, v2f, swb8, e << pos);
    float tc[NS], ts[NS];
    if (twb) {
#pragma unroll
      for (int u = 0; u < NS; ++u) { tc[u] = twb->c[u]; ts[u] = twb->s[u]; asm volatile("" : "+v"(tc[u]), "+v"(ts[u])); }
    } else {
      float rev = (float)lo * (1.0f / (float)(1 << (13 - S0)));
      tc[0] = cosrev(rev); ts[0] = sinrev(rev);
#pragma unroll
      for (int u = 1; u < NS; ++u) { tc[u] = tc[u - 1] * tc[u - 1] - ts[u - 1] * ts[u - 1]; ts[u] = 2.0f * tc[u - 1] * ts[u - 1]; }
    }
    if (!INV) {
#pragma unroll
      for (int u = 0; u < NS; ++u) {
        const int bit = 1 << (NS - 1 - u);
#pragma unroll
        for (int e = 0; e < R; ++e) {
          if (e & bit) continue;
          const int k16 = (e & (bit - 1)) << (4 - NS + u);
          float c, sn;
          if (k16 == 0) { c = tc[u]; sn = ts[u]; }
          else if (k16 == 4) { c = -ts[u]; sn = tc[u]; }
          else { c = tc[u] * C16(k16) - ts[u] * S16(k16); sn = ts[u] * C16(k16) + tc[u] * S16(k16); }
          v2f a = v[e], bb = v[e | bit];
          v2f d = a - bb;
          v[e] = a + bb;
          v2f t1 = d * (v2f){c, c};
          v[e | bit] = __builtin_elementwise_fma((v2f){d.y, d.x}, (v2f){sn, -sn}, t1);
        }
      }
    } else {
#pragma unroll
      for (int u = NS - 1; u >= 0; --u) {
        const int bit = 1 << (NS - 1 - u);
#pragma unroll
        for (int e = 0; e < R; ++e) {
          if (e & bit) continue;
          const int k16 = (e & (bit - 1)) << (4 - NS + u);
          float c, sn;
          if (k16 == 0) { c = tc[u]; sn = ts[u]; }
          else if (k16 == 4) { c = -ts[u]; sn = tc[u]; }
          else { c = tc[u] * C16(k16) - ts[u] * S16(k16); sn = ts[u] * C16(k16) + tc[u] * S16(k16); }
          v2f a = v[e], bb = v[e | bit];
          v2f t1 = bb * (v2f){c, c};
          v2f t = __builtin_elementwise_fma((v2f){bb.y, bb.x}, (v2f){-sn, sn}, t1);
          v[e] = a + t;
          v[e | bit] = a - t;
        }
      }
    }
#pragma unroll
    for (int e = 0; e < R; ++e) {
      if (TOKS) DSW(KSout, v2f, swb8, e << pos) = v[e] * (v2f){1.0f / 8192.0f, 1.0f / 8192.0f};
      else DSW(D, v2f, swb8, e << pos) = v[e];
    }
  }
}

__device__ __forceinline__ int opaque_tid_fwd() {
  int t = threadIdx.x;
  asm volatile("" : "+v"(t));
  return t;
}
__device__ __forceinline__ void fft_mid(float2* Df, const float2* KSf, int tid0) {
  v2f* D = (v2f*)Df;
  const v2f* KS = (const v2f*)KSf;
  const int base = tid0 << 4;
  v2f v[16];
  const int swb8 = SW(base) << 3;
#pragma unroll
  for (int e = 0; e < 16; ++e) v[e] = DSW(D, v2f, swb8, e);
#pragma unroll
  for (int u = 0; u < 4; ++u) {
    const int bit = 1 << (3 - u);
    const float scale = 1.0f / (float)(1 << (4 - u));
#pragma unroll
    for (int e = 0; e < 16; ++e) {
      if (e & bit) continue;
      const int k16 = (e & (bit - 1)) << u;
      const float c = C16(k16), sn = S16(k16);
      v2f a = v[e], bb = v[e | bit];
      v2f d = a - bb;
      v[e] = a + bb;
      if (k16 == 0) v[e | bit] = d;
      else if (k16 == 4) v[e | bit] = (v2f){d.y, -d.x};
      else {
        v2f t1 = d * (v2f){c, c};
        v[e | bit] = __builtin_elementwise_fma((v2f){d.y, d.x}, (v2f){sn, -sn}, t1);
      }
    }
  }
#pragma unroll
  for (int e = 0; e < 16; ++e) {
    v2f k = DSW(KS, const v2f, swb8, e);
    v2f a = v[e];
    v2f t1 = a * (v2f){k.x, k.x};
    v[e] = __builtin_elementwise_fma((v2f){a.y, a.x}, (v2f){-k.y, k.y}, t1);
  }
#pragma unroll
  for (int u = 3; u >= 0; --u) {
    const int bit = 1 << (3 - u);
    const float scale = 1.0f / (float)(1 << (4 - u));
#pragma unroll
    for (int e = 0; e < 16; ++e) {
      if (e & bit) continue;
      const int k16 = (e & (bit - 1)) << u;
      const float c = C16(k16), sn = S16(k16);
      v2f a = v[e], bb = v[e | bit];
      v2f t;
      if (k16 == 0) t = bb;
      else if (k16 == 4) t = (v2f){-bb.y, bb.x};
      else {
        v2f t1 = bb * (v2f){c, c};
        t = __builtin_elementwise_fma((v2f){bb.y, bb.x}, (v2f){-sn, sn}, t1);
      }
      v[e] = a + t;
      v[e | bit] = a - t;
    }
  }
#pragma unroll
  for (int e = 0; e < 16; ++e) DSW(D, v2f, swb8, e) = v[e];
}
__device__ __forceinline__ int opaque_tid() {
  int t = threadIdx.x;
  asm volatile("" : "+v"(t));
  return t;
}
__device__ __forceinline__ void fft_conv(float2* D, const float2* KS, const TwBase& tw1, const TwBase& tw5) {
  const int t = opaque_tid();
  fft_pass<4, 1, false>(D, t, nullptr, &tw1); __syncthreads();
  fft_pass<4, 5, false>(D, t, nullptr, &tw5); __syncthreads();
  fft_mid(D, KS, t); __syncthreads();
  fft_pass<4, 5, true>(D, t, nullptr, &tw5); __syncthreads();
  fft_pass<4, 1, true>(D, t, nullptr, &tw1); __syncthreads();
}
__device__ __forceinline__ void fft_fwd(float2* D, float2* KS, const TwBase& tw1, const TwBase& tw5) {
  const int t = opaque_tid();
  fft_pass<4, 1, false>(D, t, nullptr, &tw1); __syncthreads();
  fft_pass<4, 5, false>(D, t, nullptr, &tw5); __syncthreads();
  fft_pass<4, 9, false, true>(D, t, KS); __syncthreads();
}

#define LOAD8(X, ROW, T)                                                          \
  float X##0, X##1, X##2, X##3, X##4, X##5, X##6, X##7, X##8, X##9;               \
  {                                                                               \
    const bf16_t* rw_ = (ROW);                                                    \
    uint4 v_ = *(const uint4*)(rw_ + 8 * (T));                                    \
    X##0 = (T) > 0 ? bf2f(rw_[8 * (T)-1]) : 0.f;                                  \
    X##9 = (T) < 511 ? bf2f(rw_[8 * (T) + 8]) : 0.f;                              \
    X##1 = bf2f(v_.x & 0xffff); X##2 = bf2f(v_.x >> 16);                          \
    X##3 = bf2f(v_.y & 0xffff); X##4 = bf2f(v_.y >> 16);                          \
    X##5 = bf2f(v_.z & 0xffff); X##6 = bf2f(v_.z >> 16);                          \
    X##7 = bf2f(v_.w & 0xffff); X##8 = bf2f(v_.w >> 16);                          \
  }
#define SC3(XM, X0, XP, W0, W1, W2, B) ((XM) * (W0) + (X0) * (W1) + (XP) * (W2) + (B))

#define LD_ST(E, XM, X0, XP, YM, Y0, YP)                                                   \
          {                                                                               \
            float a0_ = SC3(XM, X0, XP, ua, ub, uc, ud), a1_ = SC3(YM, Y0, YP, ua, ub, uc, ud); \
            float rv_ = (float)(i0 + (E)) * (1.0f / 8192.0f);                             \
            float c_ = cosrev(rv_), s_ = sinrev(rv_);                                     \
            DSW(D, float2, sw0, (E)) = make_float2(a0_, a1_);                                \
            DSW(D + 4096, float2, sw0, (E)) = make_float2(a0_ * c_ + a1_ * s_, a1_ * c_ - a0_ * s_); \
          }
#define RD_Y(E)                                                                           \
          float2 y##E;                                                                    \
          {                                                                               \
            float2 A_ = DSW(D, float2, sw0, (E)), B_ = DSW(D + 4096, float2, sw0, (E));     \
            float rv_ = (float)(i0 + (E)) * (1.0f / 8192.0f);                             \
            float c_ = cosrev(rv_), s_ = sinrev(rv_);                                     \
            y##E = make_float2(A_.x + B_.x * c_ - B_.y * s_, A_.y + B_.x * s_ + B_.y * c_); \
          }
#define OUTA(E, XM, X0, XP, GM, G0, GP) (SC3(GM, G0, GP, wg0, wg1, wg2, bg) * (y##E.x + bias * SC3(XM, X0, XP, ua, ub, uc, ud)))
#define OUTB(E, XM, X0, XP, GM, G0, GP) (SC3(GM, G0, GP, wg0, wg1, wg2, bg) * (y##E.y + bias * SC3(XM, X0, XP, ua, ub, uc, ud)))
__device__ void phase_hyena(unsigned char* smem, const Params& P) {
  const int tid = threadIdx.x;
  float2* D = (float2*)smem;
  float2* KS = D + 8192;
  bf16_t* Z = (bf16_t*)(P.ws + OFF_Z);
  bf16_t* Z1 = (bf16_t*)(P.ws + OFF_Z1);
  const float* filt = (const float*)(P.ws + OFF_FILT);
  const float* cw = P.in[18]; const float* cb = P.in[19]; const float* hbias = P.in[27];
  const TwBase tw1 = make_twbase<1>(tid & 255), tw5 = make_twbase<5>(tid & 15);
#pragma unroll 1
  for (int c = blockIdx.x; c < 512; c += gridDim.x) {
    bf16_t* Zv = Z + (size_t)c * 8 * 4096;
    bf16_t* Zm = Z1 + (size_t)c * 8 * 4096;
    const float wv0 = cw[c], wv1 = cw[1536 + c], wv2 = cw[3072 + c], bv = cb[c];
#pragma unroll 1
    for (int order = 0; order < 2; ++order) {
      const float* hf = filt + ((size_t)((order * 2 + 0) * 512 + c)) * 4096;
      const float* hb = filt + ((size_t)((order * 2 + 1) * 512 + c)) * 4096;
#pragma unroll 2
      for (int i = tid; i < 4096; i += NT) {
        const float lo_v = hf[i];
        const float up_v = i == 0 ? 0.f : hb[4096 - i];
        const float a = lo_v + up_v, d = lo_v - up_v;
        const float rv = (float)i * (1.0f / 8192.0f);
        D[SW(i)] = make_float2(a, 0.f);
        D[SW(i + 4096)] = make_float2(d * cosrev(rv), -d * sinrev(rv));
      }
      __syncthreads();
      fft_fwd(D, KS, tw1, tw5);
      const int cgi = (order == 0 ? 512 : 1024) + c;
      const bf16_t* Zg = Z + (size_t)cgi * 8 * 4096;
      const float wg0 = cw[cgi], wg1 = cw[1536 + cgi], wg2 = cw[3072 + cgi], bg = cb[cgi];
      const float bias = hbias[order * 512 + c];
      const float ua = order == 0 ? wv0 : 0.f, ub = order == 0 ? wv1 : 1.f, uc = order == 0 ? wv2 : 0.f, ud = order == 0 ? bv : 0.f;
#define RAW_LOAD(R, ROW, T)                                              \
      {                                                                      \
        const bf16_t* rw_ = (ROW);                                           \
        R##v = *(const uint4*)(rw_ + 8 * (T));                               \
        R##p = (T) > 0 ? rw_[8 * (T)-1] : (bf16_t)0;                         \
        R##n = (T) < 511 ? rw_[8 * (T) + 8] : (bf16_t)0;                     \
      }
#define RAW_UNPACK(X, R)                                                     \
      const float X##0 = bf2f(R##p), X##9 = bf2f(R##n),                      \
                  X##1 = bf2f(R##v.x & 0xffff), X##2 = bf2f(R##v.x >> 16),   \
                  X##3 = bf2f(R##v.y & 0xffff), X##4 = bf2f(R##v.y >> 16),   \
                  X##5 = bf2f(R##v.z & 0xffff), X##6 = bf2f(R##v.z >> 16),   \
                  X##7 = bf2f(R##v.w & 0xffff), X##8 = bf2f(R##v.w >> 16);
      const bf16_t* rin = (order == 0 ? Zv : Zm);
      uint4 rav, rbv, rgv, rhv; bf16_t rap, ran, rbp, rbn, rgp, rgn, rhp, rhn;
      RAW_LOAD(ra, rin, tid)
      RAW_LOAD(rb, rin + 4096, tid)
#pragma unroll 1
      for (int pair = 0; pair < 4; ++pair) {
        const uint4 sav = rav, sbv = rbv; const bf16_t sap = rap, san = ran, sbp = rbp, sbn = rbn;
        {
          RAW_UNPACK(xa, ra)
          RAW_UNPACK(xb, rb)
          int i0 = 8 * tid;
          asm volatile("" : "+v"(i0));
          const int sw0 = SW(i0) << 3;
          LD_ST(0, xa0, xa1, xa2, xb0, xb1, xb2)
          LD_ST(1, xa1, xa2, xa3, xb1, xb2, xb3)
          LD_ST(2, xa2, xa3, xa4, xb2, xb3, xb4)
          LD_ST(3, xa3, xa4, xa5, xb3, xb4, xb5)
          LD_ST(4, xa4, xa5, xa6, xb4, xb5, xb6)
          LD_ST(5, xa5, xa6, xa7, xb5, xb6, xb7)
          LD_ST(6, xa6, xa7, xa8, xb6, xb7, xb8)
          LD_ST(7, xa7, xa8, xa9, xb7, xb8, xb9)
        }
        RAW_LOAD(rg, Zg + (size_t)(2 * pair) * 4096, tid)
        RAW_LOAD(rh, Zg + (size_t)(2 * pair + 1) * 4096, tid)
        {
          const int np = pair < 3 ? pair + 1 : pair;
          RAW_LOAD(ra, rin + (size_t)(2 * np) * 4096, tid)
          RAW_LOAD(rb, rin + (size_t)(2 * np + 1) * 4096, tid)
        }
        __syncthreads();
        fft_conv(D, KS, tw1, tw5);
        {
          bf16_t* o0 = (order == 0 ? Zm : Zv) + (size_t)(2 * pair) * 4096;
          bf16_t* o1 = o0 + 4096;
          RAW_UNPACK(ga, rg)
          RAW_UNPACK(gb, rh)
          RAW_UNPACK(xa, sa)
          RAW_UNPACK(xb, sb)
          int i0 = 8 * tid;
          asm volatile("" : "+v"(i0));
          const int sw0 = SW(i0) << 3;
          RD_Y(0) RD_Y(1) RD_Y(2) RD_Y(3) RD_Y(4) RD_Y(5) RD_Y(6) RD_Y(7)
          uint4 pa, pb;
          pa.x = pack2(OUTA(0, xa0, xa1, xa2, ga0, ga1, ga2), OUTA(1, xa1, xa2, xa3, ga1, ga2, ga3));
          pa.y = pack2(OUTA(2, xa2, xa3, xa4, ga2, ga3, ga4), OUTA(3, xa3, xa4, xa5, ga3, ga4, ga5));
          pa.z = pack2(OUTA(4, xa4, xa5, xa6, ga4, ga5, ga6), OUTA(5, xa5, xa6, xa7, ga5, ga6, ga7));
          pa.w = pack2(OUTA(6, xa6, xa7, xa8, ga6, ga7, ga8), OUTA(7, xa7, xa8, xa9, ga7, ga8, ga9));
          pb.x = pack2(OUTB(0, xb0, xb1, xb2, gb0, gb1, gb2), OUTB(1, xb1, xb2, xb3, gb1, gb2, gb3));
          pb.y = pack2(OUTB(2, xb2, xb3, xb4, gb2, gb3, gb4), OUTB(3, xb3, xb4, xb5, gb3, gb4, gb5));
          pb.z = pack2(OUTB(4, xb4, xb5, xb6, gb4, gb5, gb6), OUTB(5, xb5, xb6, xb7, gb5, gb6, gb7));
          pb.w = pack2(OUTB(6, xb6, xb7, xb8, gb6, gb7, gb8), OUTB(7, xb7, xb8, xb9, gb7, gb8, gb9));
          *(uint4*)(o0 + i0) = pa;
          *(uint4*)(o1 + i0) = pb;
        }
        __syncthreads();
      }
    }
  }
}


#define XB_TMO      128
#define XB_XCNT(j)  (256  + 64 * (j))
#define XB_XSUB(j)  (1280 + 64 * (j))
#define XB_XGEN(j)  (2304 + 64 * (j))
#define XB_TOP      3328
#define XB_TOPGEN   3392
#define XCD_BAR_WORDS 3456
#define XB_SPIN_CAP (1u << 18)
#define LAS __attribute__((address_space(3)))
__device__ __forceinline__ unsigned xb_ld(unsigned* p) { return __hip_atomic_load(p, __ATOMIC_RELAXED, __HIP_MEMORY_SCOPE_AGENT); }
__device__ __forceinline__ unsigned xb_add(unsigned* p, unsigned v) { return __hip_atomic_fetch_add(p, v, __ATOMIC_RELAXED, __HIP_MEMORY_SCOPE_AGENT); }
__device__ __forceinline__ unsigned xb_xcc_id() { return (unsigned)__builtin_amdgcn_s_getreg((3 << 11) | 20) & 0xFu; }
#define XB_SPIN(cond, bar) do { unsigned _sp = 0; while (cond) { __builtin_amdgcn_s_sleep(1); \
    if ((++_sp & 255u) == 0u) { if (xb_ld(&(bar)[XB_TMO])) break; if (_sp > XB_SPIN_CAP) { atomicAdd(&(bar)[XB_TMO], 1u); break; } } } } while (0)
struct XcdBarrier { unsigned* bar; unsigned x; volatile LAS unsigned* st; };
__device__ __forceinline__ XcdBarrier xcd_barrier_post(unsigned* bar, volatile LAS unsigned* st) {
  XcdBarrier b; b.bar = bar; b.x = xb_xcc_id(); b.st = st;
  if (threadIdx.x == 0) (void)xb_add(&bar[XB_XCNT(b.x)], 1u);
  return b;
}
__device__ __forceinline__ void xcd_barrier_complete(unsigned* bar, unsigned x, unsigned& nloc, unsigned& nx) {
  const unsigned G = gridDim.x * gridDim.y * gridDim.z;
  unsigned sum, cnt, mine, sp = 0u;
  for (;;) {
    sum = 0u; cnt = 0u; mine = 0u;
#pragma unroll
    for (unsigned j = 0; j < 16; ++j) { const unsigned c = xb_ld(&bar[XB_XCNT(j)]); sum += c; cnt += (c > 0u) ? 1u : 0u; mine = (j == x) ? c : mine; }
    if (sum == G) break;
    __builtin_amdgcn_s_sleep(1);
    if ((++sp & 255u) == 0u) { if (xb_ld(&bar[XB_TMO])) break; if (sp > XB_SPIN_CAP) { atomicAdd(&bar[XB_TMO], 1u); break; } }
  }
  nloc = mine > 0u ? mine : 1u; nx = cnt > 0u ? cnt : 1u;
}
__device__ __forceinline__ void xcd_barrier(unsigned* bar_, volatile LAS unsigned* st_) {
  asm volatile("s_waitcnt vmcnt(0)" ::: "memory");
  __syncthreads();
  if (threadIdx.x == 0) {
    XcdBarrier b; b.bar = bar_; b.x = xb_xcc_id(); b.st = st_;
    unsigned* bar = b.bar;
    __builtin_amdgcn_s_waitcnt(0);
    unsigned nloc = b.st[0], nx = b.st[1];
    if (nloc == 0u) { xcd_barrier_complete(bar, b.x, nloc, nx); b.st[0] = nloc; b.st[1] = nx; }
    const unsigned old = xb_add(&bar[XB_XSUB(b.x)], 1u);
    const unsigned gen = old / nloc;
    if (old + 1u == (gen + 1u) * nloc) {
      __builtin_amdgcn_fence(__ATOMIC_RELEASE, "agent");
      asm volatile("s_waitcnt vmcnt(0)" ::: "memory");
      const unsigned og = xb_add(&bar[XB_TOP], 1u);
      const unsigned tg = og / nx;
      if (og + 1u == (tg + 1u) * nx) xb_add(&bar[XB_TOPGEN], 1u);
      else XB_SPIN(xb_ld(&bar[XB_TOPGEN]) == tg, bar);
      __builtin_amdgcn_fence(__ATOMIC_ACQUIRE, "agent");
      xb_add(&bar[XB_XGEN(b.x)], 1u);
      asm volatile("s_waitcnt vmcnt(0)" ::: "memory");
    } else {
      XB_SPIN(xb_ld(&bar[XB_XGEN(b.x)]) == gen, bar);
      __builtin_amdgcn_fence(__ATOMIC_ACQUIRE, "agent");
      asm volatile("s_waitcnt vmcnt(0)" ::: "memory");
    }
  }
  __syncthreads();
}

#define PHASE(k, call)                                   \
  {                                                        \
    if ((k) == 1) grid.sync();                             \
    else if ((k) > 1) xcd_barrier((unsigned*)(P.ws + OFF_BAR), (volatile LAS unsigned*)(smem + 131072)); \
    call;                                                  \
  }
__global__ void __launch_bounds__(NT) fwd_kernel(Params P) {
  extern __shared__ __attribute__((aligned(16))) unsigned char smem[];
  cg::grid_group grid = cg::this_grid();
  volatile LAS unsigned* xst = (volatile LAS unsigned*)(smem + 131072);
  if (threadIdx.x < 2) xst[threadIdx.x] = 0u;
  __syncthreads();
  (void)xcd_barrier_post((unsigned*)(P.ws + OFF_BAR), xst);
  PHASE(0, phase0(smem, P))
  PHASE(1, phase_rownorm(P, 3); xcd_barrier((unsigned*)(P.ws + OFF_BAR), (volatile LAS unsigned*)(smem + 131072));
           if (blockIdx.x < 16) phase_gemm1(smem, P, 1); else phase_rownorm(P, 0))
  PHASE(2, phase_gemm1(smem, P, 0))
  PHASE(3, phase_s5g1(smem, P))
  PHASE(4, phase_s5scan(P))
  PHASE(5, phase_s5g2(smem, P))
  PHASE(6, phase_glu(smem, P); phase_hyena(smem, P))
  PHASE(8, phase_mixnorm(smem, P))
  PHASE(9, phase_wout(smem, P))
  PHASE(10, phase_rownorm(P, 1))
  PHASE(11, phase_mlp1(smem, P))
  PHASE(12, phase_mlp2(smem, P))
  PHASE(13, phase_rownorm(P, 2))
}

extern "C" void kernel_launch(void* const* d_in, const int* in_sizes, int n_in, void* d_out, int out_size, void* d_ws,
                              size_t ws_size, hipStream_t stream) {
  static int grid_blocks = 0;
  if (!grid_blocks) {
    int dev = 0, cus = 0, per_cu = 0;
    (void)hipGetDevice(&dev);
    (void)hipDeviceGetAttribute(&cus, hipDeviceAttributeMultiprocessorCount, dev);
    (void)hipFuncSetAttribute((const void*)fwd_kernel, hipFuncAttributeMaxDynamicSharedMemorySize, LDS_BYTES);
    (void)hipOccupancyMaxActiveBlocksPerMultiprocessor(&per_cu, (const void*)fwd_kernel, NT, LDS_BYTES);
    if (per_cu < 1) per_cu = 1;
    if (cus < 1) cus = 256;
    grid_blocks = cus * per_cu;
    (void)hipGetLastError();
  }
  if (n_in != 35 || ws_size < WS_NEED) {
    fprintf(stderr, "kernel_launch: unexpected n_in %d or ws_size %zu\n", n_in, ws_size);
    return;
  }
  Params p;
  memset(&p, 0, sizeof(p));
  for (int i = 0; i < 35; ++i) p.in[i] = (const float*)d_in[i];
  p.out = (float*)d_out;
  p.ws = (unsigned char*)d_ws;
  (void)hipMemsetAsync((unsigned char*)d_ws + OFF_BAR, 0, XCD_BAR_WORDS * sizeof(unsigned), stream);
  p.ph_lo = 0; p.ph_hi = N_PHASES;
  void* args[] = {&p};
  hipError_t e = hipLaunchCooperativeKernel((const void*)fwd_kernel, dim3(grid_blocks), dim3(NT), args, LDS_BYTES, stream);
  if (e != hipSuccess) fprintf(stderr, "cooperative launch failed: %s (grid %d)\n", hipGetErrorString(e), grid_blocks);
}
```
